# Optimizing an MI355X kernel written in HIP

```python
import jax, jax.numpy as jnp
from jax import lax
import numpy as np

D_MODEL = 4096
BATCH = 4
SEQ = 4096
DEPTH = 2

GRID_W = 64
CTX_LEN = 256
N_MIXERS = 2
HEAD_DIM = 128
N_Q_HEADS = D_MODEL // HEAD_DIM
N_KV_HEADS = N_Q_HEADS // 4
Q_BLOCK = 128
D_FF = 4 * D_MODEL
CONV_WIDTH = 3
ROPE_THETA = 10000.0
LN_EPS = 1e-5
RMS_EPS = 1e-6
N_MOD = 6
N_CONV_LAYERS = (DEPTH + 1) // 2
N_ATTN_LAYERS = DEPTH // 2
DEEPNORM_ALPHA = (2 * DEPTH) ** 0.25
DEEPNORM_BETA = (8 * DEPTH) ** -0.25

kernel_name = "hybrid_conv_gqa_deepnorm_dit"


def layer_norm(x, g, b):
    xf = x.astype(jnp.float32)
    mu = jnp.mean(xf, axis=-1, keepdims=True)
    var = jnp.mean(jnp.square(xf - mu), axis=-1, keepdims=True)
    y = (xf - mu) * lax.rsqrt(var + LN_EPS) * g.astype(jnp.float32) + b.astype(jnp.float32)
    return y.astype(x.dtype)


def rms_norm(x, g):
    xf = x.astype(jnp.float32)
    y = xf * lax.rsqrt(jnp.mean(xf * xf, axis=-1, keepdims=True) + RMS_EPS) * g.astype(jnp.float32)
    return y.astype(x.dtype)


def adaln(cond, w, b):
    m = jnp.dot(jax.nn.silu(cond), w) + b
    m = m.reshape(-1, 1, N_MOD * D_MODEL)
    return jnp.split(m, N_MOD, axis=-1)


def modulate(h, shift, scale):
    return h * (1.0 + scale) + shift


def axial_rope_tables(seq):
    rows = seq // GRID_W
    row = jnp.repeat(jnp.arange(rows), GRID_W)
    col = jnp.tile(jnp.arange(GRID_W), rows)
    half = HEAD_DIM // 2
    inv_freq = ROPE_THETA ** (-jnp.arange(0, half, 2, dtype=jnp.float32) / half)

    def axis_angles(pos):
        ang = pos.astype(jnp.float32)[:, None] * inv_freq[None, :]
        return jnp.concatenate([ang, ang], axis=-1)

    ang = jnp.concatenate([axis_angles(row), axis_angles(col)], axis=-1)
    return jnp.cos(ang), jnp.sin(ang)


def apply_axial_rope(x, cos, sin):
    xf = x.astype(jnp.float32)
    quarter = HEAD_DIM // 4
    xa = xf.reshape(*xf.shape[:-1], 2, 2, quarter)
    rot = jnp.stack([-xa[..., 1, :], xa[..., 0, :]], axis=-2).reshape(xf.shape)
    return (xf * cos[None, :, None, :] + rot * sin[None, :, None, :]).astype(x.dtype)


def short_conv_mixer(h, w_in, conv_w, conv_b, w_out):
    gate_b, gate_c, v = jnp.split(jnp.dot(h, w_in), 3, axis=-1)
    u = gate_c * v
    length = u.shape[1]
    up = jnp.pad(u, ((0, 0), (1, 1), (0, 0)))
    conv = (up[:, :length] * conv_w[0] + up[:, 1:length + 1] * conv_w[1]
            + up[:, 2:length + 2] * conv_w[2] + conv_b)
    return jnp.dot(gate_b * conv, w_out)


def attend(q, k, v):
    s = jnp.einsum('bqkgd,bskd->bkgqs', q, k, preferred_element_type=jnp.float32) * (HEAD_DIM ** -0.5)
    p = jax.nn.softmax(s, axis=-1).astype(v.dtype)
    return jnp.einsum('bkgqs,bskd->bqkgd', p, v)


def gqa_axial_attention(h_lat, h_ctx, w_qkv, q_gain, k_gain, w_o, cos, sin, need_ctx_out):
    bsz, seq, _ = h_lat.shape
    ctx_len = h_ctx.shape[1]
    grp = N_Q_HEADS // N_KV_HEADS
    q_dim = N_Q_HEADS * HEAD_DIM
    kv_dim = N_KV_HEADS * HEAD_DIM

    def split_kv(kv, length):
        k, v = jnp.split(kv, 2, axis=-1)
        k = rms_norm(k.reshape(bsz, length, N_KV_HEADS, HEAD_DIM), k_gain)
        return k, v.reshape(bsz, length, N_KV_HEADS, HEAD_DIM)

    qkv_l = jnp.dot(h_lat, w_qkv)
    q_l = rms_norm(qkv_l[..., :q_dim].reshape(bsz, seq, N_Q_HEADS, HEAD_DIM), q_gain)
    k_l, v_l = split_kv(qkv_l[..., q_dim:], seq)
    q_l = apply_axial_rope(q_l, cos, sin)
    k_l = apply_axial_rope(k_l, cos, sin)

    k_c, v_c = split_kv(jnp.dot(h_ctx, w_qkv[:, q_dim:q_dim + 2 * kv_dim]), ctx_len)

    k_all = jnp.concatenate([k_c, k_l], axis=1)
    v_all = jnp.concatenate([v_c, v_l], axis=1)
    n_blk = seq // Q_BLOCK
    q_blocks = q_l.reshape(bsz, n_blk, Q_BLOCK, N_KV_HEADS, grp, HEAD_DIM).transpose(1, 0, 2, 3, 4, 5)
    o = lax.map(lambda qb: attend(qb, k_all, v_all), q_blocks)
    o_lat = o.transpose(1, 0, 2, 3, 4, 5).reshape(bsz, seq, q_dim)
    y_lat = jnp.dot(o_lat, w_o)

    y_ctx = None
    if need_ctx_out:
        q_c = rms_norm(jnp.dot(h_ctx, w_qkv[:, :q_dim]).reshape(bsz, ctx_len, N_Q_HEADS, HEAD_DIM), q_gain)
        o_ctx = attend(q_c.reshape(bsz, ctx_len, N_KV_HEADS, grp, HEAD_DIM), k_c, v_c)
        y_ctx = jnp.dot(o_ctx.reshape(bsz, ctx_len, q_dim), w_o)
    return y_lat, y_ctx


def sqrelu_mlp(h, w1, w2):
    return jnp.dot(jnp.square(jax.nn.relu(jnp.dot(h, w1))), w2)


def setup_inputs(seed: int = 0) -> dict:
    key = jax.random.key(seed)
    ks = jax.random.split(key, 20)
    d = D_MODEL
    q_dim = N_Q_HEADS * HEAD_DIM
    kv_dim = N_KV_HEADS * HEAD_DIM

    def nrm(k, shape, s):
        return jax.random.normal(k, shape, jnp.float32) * s

    w_qk = nrm(ks[14], (N_ATTN_LAYERS, d, q_dim + kv_dim), d ** -0.5)
    w_v = nrm(ks[15], (N_ATTN_LAYERS, d, kv_dim), DEEPNORM_BETA * d ** -0.5)
    return {
        "x": nrm(ks[0], (BATCH, SEQ, d), 1.0),
        "c": nrm(ks[1], (BATCH, d), 1.0),
        "ctx": nrm(ks[2], (BATCH, CTX_LEN, d), 1.0),
        "c_ctx": nrm(ks[3], (d,), 1.0),
        "ada_w": nrm(ks[4], (DEPTH, d, N_MOD * d), 0.5 * d ** -0.5),
        "ada_b": nrm(ks[5], (DEPTH, N_MOD * d), 0.02),
        "ln_g": 1.0 + nrm(ks[6], (DEPTH, 2, d), 0.02),
        "ln_b": nrm(ks[7], (DEPTH, 2, d), 0.02),
        "mlp_w1": nrm(ks[8], (DEPTH, d, D_FF), d ** -0.5),
        "mlp_w2": nrm(ks[9], (DEPTH, D_FF, d), DEEPNORM_BETA * D_FF ** -0.5),
        "conv_in_w": nrm(ks[10], (N_CONV_LAYERS, d, 3 * d), d ** -0.5),
        "conv_w": nrm(ks[11], (N_CONV_LAYERS, CONV_WIDTH, d), CONV_WIDTH ** -0.5),
        "conv_b": nrm(ks[12], (N_CONV_LAYERS, d), 0.02),
        "conv_out_w": nrm(ks[13], (N_CONV_LAYERS, d, d), DEEPNORM_BETA * d ** -0.5),
        "attn_qkv_w": jnp.concatenate([w_qk, w_v], axis=-1),
        "attn_q_gain": 1.0 + nrm(ks[16], (N_ATTN_LAYERS, HEAD_DIM), 0.02),
        "attn_k_gain": 1.0 + nrm(ks[17], (N_ATTN_LAYERS, HEAD_DIM), 0.02),
        "attn_out_w": nrm(ks[18], (N_ATTN_LAYERS, q_dim, d), DEEPNORM_BETA * q_dim ** -0.5),
    }


def reference(x, c, ctx, c_ctx, ada_w, ada_b, ln_g, ln_b, mlp_w1, mlp_w2, conv_in_w, conv_w, conv_b,
              conv_out_w, attn_qkv_w, attn_q_gain, attn_k_gain, attn_out_w):
    cos, sin = axial_rope_tables(x.shape[1])
    h_lat, h_ctx = x, ctx
    for i in range(DEPTH):
        need_ctx_out = i < DEPTH - 1
        j = i // N_MIXERS
        ml = adaln(c, ada_w[i], ada_b[i])
        mc = adaln(c_ctx, ada_w[i], ada_b[i])

        a_lat = modulate(h_lat, ml[0], ml[1])
        a_ctx = modulate(h_ctx, mc[0], mc[1])
        if i % N_MIXERS == 0:
            y_lat = short_conv_mixer(a_lat, conv_in_w[j], conv_w[j], conv_b[j], conv_out_w[j])
            y_ctx = (short_conv_mixer(a_ctx, conv_in_w[j], conv_w[j], conv_b[j], conv_out_w[j])
                     if need_ctx_out else None)
        else:
            y_lat, y_ctx = gqa_axial_attention(a_lat, a_ctx, attn_qkv_w[j], attn_q_gain[j], attn_k_gain[j],
                                               attn_out_w[j], cos, sin, need_ctx_out)
        h_lat = layer_norm(DEEPNORM_ALPHA * h_lat + ml[2] * y_lat, ln_g[i, 0], ln_b[i, 0])
        if need_ctx_out:
            h_ctx = layer_norm(DEEPNORM_ALPHA * h_ctx + mc[2] * y_ctx, ln_g[i, 0], ln_b[i, 0])

        y_lat = sqrelu_mlp(modulate(h_lat, ml[3], ml[4]), mlp_w1[i], mlp_w2[i])
        h_lat = layer_norm(DEEPNORM_ALPHA * h_lat + ml[5] * y_lat, ln_g[i, 1], ln_b[i, 1])
        if need_ctx_out:
            y_ctx = sqrelu_mlp(modulate(h_ctx, mc[3], mc[4]), mlp_w1[i], mlp_w2[i])
            h_ctx = layer_norm(DEEPNORM_ALPHA * h_ctx + mc[5] * y_ctx, ln_g[i, 1], ln_b[i, 1])
    return h_lat
```

```cpp
#include <hip/hip_runtime.h>
#include <hip/hip_bf16.h>
#include <cstdio>
#include <cstdint>
namespace pg8 {
#define PG8_LAS __attribute__((address_space(3)))
typedef unsigned short bf16_t;
typedef short bf16x8 __attribute__((ext_vector_type(8)));
typedef float f32x4 __attribute__((ext_vector_type(4)));
typedef unsigned u32x4 __attribute__((ext_vector_type(4)));
typedef float f32x2 __attribute__((ext_vector_type(2)));
constexpr int BM = 256, BK = 64, HALF = 128, HTB = HALF * BK * 2  , STAGE_BYTES = 8 * HTB, NXCD = 8, WGM = 8;

__host__ __device__ __forceinline__ int lds_byte(int r, int c) { return r * 128 + ((((c >> 3) ^ (r >> 1)) & 7) << 4) + (c & 7) * 2; }
__host__ __device__ __forceinline__ void stage_rc(int b, int& R, int& C) { R = b >> 7; C = ((((b >> 4) ^ (R >> 1)) & 7) << 3); }
__host__ __device__ __forceinline__ int perm32(int rho) { const int n = rho >> 4, i = rho & 15; return 8 * (i >> 2) + 4 * n + (i & 3); }

struct Unit { int pm, pn, kt0, nkt, part; };
struct Gemm { const bf16_t* A; const bf16_t* Bt; int M, N, K; };

struct StaticOrder {
    int nM, nN, nwg, G, c, nkt;
    __host__ __device__ void init(int M, int N, int K, int G_, int c_) { nM = M / BM; nN = N / BM; nwg = nM * nN; G = G_; c = c_; nkt = K / BK; }
    __host__ __device__ void map(int L, int& pm, int& pn) const {
        const int wgid = L;
        const int nig = WGM * nN, gid = wgid / nig, fm = gid * WGM, gsz = (nM - fm) < WGM ? (nM - fm) : WGM;
        pm = fm + ((wgid % nig) % gsz); pn = (wgid % nig) / gsz;
    }
    __host__ __device__ bool next(int i, Unit& u) const {
        const long L = (long)i * G + c; if (L >= nwg) return false;
        int pm, pn; map((int)L, pm, pn); Unit r; r.pm = pm; r.pn = pn; r.kt0 = 0; r.nkt = nkt; r.part = 0; u = r; return true;
    }
    __device__ __forceinline__ void a_ready(const Unit&) const {}
    __device__ __forceinline__ void done(const Unit&) const {}
};

__device__ __forceinline__ unsigned cvt_pk_bf16(float lo, float hi) { unsigned r; asm volatile("v_cvt_pk_bf16_f32 %0, %1, %2" : "=v"(r) : "v"(lo), "v"(hi)); return r; }
__device__ __forceinline__ u32x4 pack8(const f32x4 v0, const f32x4 v1) { u32x4 w; w.x = cvt_pk_bf16(v0[0], v0[1]); w.y = cvt_pk_bf16(v0[2], v0[3]); w.z = cvt_pk_bf16(v1[0], v1[1]); w.w = cvt_pk_bf16(v1[2], v1[3]); return w; }

struct EpiConvIn {
    static constexpr bool PERM = true, AFTER_DRAIN = false;
    bf16_t* GB; bf16_t* U;
    __device__ __forceinline__ void operator()(const f32x4 (&acc)[2][2][4][2], const Unit& u, int wr, int wc, int fr, int fq) const {
        const int row0 = u.pm * BM + wr * 64 + fr;
        if (u.pn < 16) {
            const int col0 = u.pn * BM + wc * 32 + 8 * fq;
#pragma unroll
            for (int ai = 0; ai < 2; ++ai)
#pragma unroll
                for (int m = 0; m < 4; ++m) { bf16_t* rowp = GB + (size_t)(row0 + ai * HALF + m * 16) * 4096 + col0;
#pragma unroll
                    for (int bj = 0; bj < 2; ++bj) *(u32x4*)(rowp + bj * HALF) = pack8(acc[ai][bj][m][0], acc[ai][bj][m][1]); }
        } else {
            const int col0 = (u.pn - 16) * HALF + wc * 32 + 8 * fq;
#pragma unroll
            for (int ai = 0; ai < 2; ++ai)
#pragma unroll
                for (int m = 0; m < 4; ++m) { bf16_t* rowp = U + (size_t)(row0 + ai * HALF + m * 16) * 4096 + col0;
                    *(u32x4*)rowp = pack8(acc[ai][0][m][0] * acc[ai][1][m][0], acc[ai][0][m][1] * acc[ai][1][m][1]); }
        }
    }
};
struct EpiSqRelu {
    static constexpr bool PERM = true, AFTER_DRAIN = false;
    bf16_t* O; int ldc;
    __device__ __forceinline__ void operator()(const f32x4 (&acc)[2][2][4][2], const Unit& u, int wr, int wc, int fr, int fq) const {
        const int row0 = u.pm * BM + wr * 64 + fr, col0 = u.pn * BM + wc * 32 + 8 * fq;
#pragma unroll
        for (int ai = 0; ai < 2; ++ai)
#pragma unroll
            for (int m = 0; m < 4; ++m) { bf16_t* rowp = O + (size_t)(row0 + ai * HALF + m * 16) * ldc + col0;
#pragma unroll
                for (int bj = 0; bj < 2; ++bj) { f32x4 v0 = __builtin_elementwise_max(acc[ai][bj][m][0], (f32x4){0.f, 0.f, 0.f, 0.f}), v1 = __builtin_elementwise_max(acc[ai][bj][m][1], (f32x4){0.f, 0.f, 0.f, 0.f});
                    *(u32x4*)(rowp + bj * HALF) = pack8(v0 * v0, v1 * v1); } }
    }
};
struct EpiQKV {
    static constexpr bool PERM = true, AFTER_DRAIN = false;
    bf16_t* Q; bf16_t* Kc; bf16_t* Vc; float* slab;
    __device__ __forceinline__ void operator()(const f32x4 (&acc)[2][2][4][2], const Unit& u, int wr, int wc, int fr, int fq) const {
        const int lr0 = wr * 64 + fr, lc0 = wc * 32 + 8 * fq;
        if (u.pm >= 64) {
            float* sb = slab + ((size_t)u.part * 1024 + (size_t)(u.pm - 64) * BM) * 2048 + (u.pn - 16) * BM + lc0;
#pragma unroll
            for (int ai = 0; ai < 2; ++ai)
#pragma unroll
                for (int m = 0; m < 4; ++m) { float* rowp = sb + (size_t)(lr0 + ai * HALF + m * 16) * 2048;
#pragma unroll
                    for (int bj = 0; bj < 2; ++bj) { *(f32x4*)(rowp + bj * HALF) = acc[ai][bj][m][0]; *(f32x4*)(rowp + bj * HALF + 4) = acc[ai][bj][m][1]; } }
            return;
        }
        bf16_t* base; int ld;
        if (u.pn < 16) { base = Q + (size_t)u.pm * BM * 4096 + u.pn * BM; ld = 4096; }
        else { const int kvrow0 = (u.pm >> 4) * 4352 + 256 + (u.pm & 15) * 256;
               base = (u.pn < 20 ? Kc + (u.pn - 16) * BM : Vc + (u.pn - 20) * BM) + (size_t)kvrow0 * 1024; ld = 1024; }
#pragma unroll
        for (int ai = 0; ai < 2; ++ai)
#pragma unroll
            for (int m = 0; m < 4; ++m) { bf16_t* rowp = base + (size_t)(lr0 + ai * HALF + m * 16) * ld + lc0;
#pragma unroll
                for (int bj = 0; bj < 2; ++bj) *(u32x4*)(rowp + bj * HALF) = pack8(acc[ai][bj][m][0], acc[ai][bj][m][1]); }
    }
};
struct EpiY {
    static constexpr bool PERM = true, AFTER_DRAIN = false;
    bf16_t* Y; bf16_t* YS;
    __device__ __forceinline__ void operator()(const f32x4 (&acc)[2][2][4][2], const Unit& u, int wr, int wc, int fr, int fq) const {
        bf16_t* base = u.part == 0 ? Y + (size_t)u.pm * BM * 4096 : YS + (size_t)(u.part - 1) * 1024 * 4096 + (size_t)(u.pm - 64) * BM * 4096;
        base += (size_t)(wr * 64 + fr) * 4096 + u.pn * BM + wc * 32 + 8 * fq;
#pragma unroll
        for (int ai = 0; ai < 2; ++ai)
#pragma unroll
            for (int m = 0; m < 4; ++m) { bf16_t* rowp = base + (size_t)(ai * HALF + m * 16) * 4096;
#pragma unroll
                for (int bj = 0; bj < 2; ++bj) *(u32x4*)(rowp + bj * HALF) = pack8(acc[ai][bj][m][0], acc[ai][bj][m][1]); }
    }
};
struct SplitOrder {
    StaticOrder so; int nlat, nsplit, nsub, nn, pn0;
    __host__ __device__ void init(int N, int K, int nsplit_, int G_, int c_, int pn0_ = 0, int nnc = -1) { so.init(16384, N, K, G_, c_); nlat = so.nwg; nsplit = nsplit_; pn0 = pn0_; nn = nnc < 0 ? N / BM : nnc; nsub = 4 * nn * nsplit; }
    __host__ __device__ bool next(int i, Unit& u) const {
        const long L = (long)i * so.G + so.c; const bool lat = L < nlat;
        int pm = 0, pn = 0; so.map((int)(lat ? L : 0), pm, pn);
        const int j = (int)(L - nlat), cu = j / nsplit, part = j % nsplit, nk = so.nkt / nsplit;
        Unit r; r.pm = lat ? pm : 64 + cu / nn; r.pn = lat ? pn : pn0 + cu % nn; r.nkt = lat ? so.nkt : nk; r.kt0 = lat ? 0 : part * nk; r.part = lat ? 0 : part;
        u = r; return lat || j < nsub;
    }
    __device__ __forceinline__ void a_ready(const Unit&) const {}
    __device__ __forceinline__ void done(const Unit&) const {}
};
template <class Epi, class Sched, bool ALIGN_EPI = false, bool SP2 = false>
__device__ __forceinline__ void gemm_phase(PG8_LAS unsigned char* lds, const Gemm g, const Sched& S, const Epi& E) {
    const int tid = threadIdx.x, wid = __builtin_amdgcn_readfirstlane(tid >> 6), lane = tid & 63, wr = wid >> 2, wc = wid & 3, fr = lane & 15, fq = lane >> 4;
    const int K = g.K;
    unsigned voffA[2], voffB[2];
#pragma unroll
    for (int i = 0; i < 2; ++i) { int R, C; stage_rc(tid * 16 + i * 8192, R, C); const int Rb = Epi::PERM ? ((R & ~31) + perm32(R & 31)) : R;
        voffA[i] = (unsigned)(R * K + C) * 2u; voffB[i] = (unsigned)(Rb * K + C) * 2u; }
    const size_t kstep = (size_t)(BK * 2);
    const size_t hstep = (size_t)HALF * K * 2;
    const size_t tstep = 2 * hstep;
    const unsigned ldsw = (unsigned)wid * 1024u;
    const int aoff0 = lds_byte(wr * 64 + fr, fq * 8), aoff1 = lds_byte(wr * 64 + fr, fq * 8 + 32), boff0 = lds_byte(wc * 32 + fr, fq * 8), boff1 = lds_byte(wc * 32 + fr, fq * 8 + 32);
#define PG8_SA(b, h) (((b) * 2 + (h)) * HTB)
#define PG8_SB(b, h) ((4 + (b) * 2 + (h)) * HTB)
#define PG8_STAGE(bufoff, gbase, voff) do { _Pragma("unroll") for (int _i = 0; _i < 2; ++_i) \
        __builtin_amdgcn_global_load_lds((const unsigned*)((const char*)(gbase) + (voff)[_i]), (PG8_LAS unsigned*)(lds + (bufoff) + ldsw + _i * 8192), 16, 0, 0); } while (0)
#define PG8_LDA(dst, b, h) do { _Pragma("unroll") for (int m = 0; m < 4; ++m) _Pragma("unroll") for (int k = 0; k < 2; ++k) dst[m][k] = *(const PG8_LAS bf16x8*)(lds + PG8_SA(b, h) + (k ? aoff1 : aoff0) + m * 2048); } while (0)
#define PG8_LDB(dst, b, h) do { _Pragma("unroll") for (int n = 0; n < 2; ++n) _Pragma("unroll") for (int k = 0; k < 2; ++k) dst[n][k] = *(const PG8_LAS bf16x8*)(lds + PG8_SB(b, h) + (k ? boff1 : boff0) + n * 2048); } while (0)
#define PG8_MMA(ai, bj, At, Bt) do { __builtin_amdgcn_s_setprio(1); _Pragma("unroll") for (int m = 0; m < 4; ++m) _Pragma("unroll") for (int n = 0; n < 2; ++n) _Pragma("unroll") for (int k = 0; k < 2; ++k) \
        acc[ai][bj][m][n] = __builtin_amdgcn_mfma_f32_16x16x32_bf16(Bt[n][k], At[m][k], acc[ai][bj][m][n], 0, 0, 0); __builtin_amdgcn_s_setprio(0); } while (0)
#define PG8_MMA_NP(ai, bj, At, Bt) do { _Pragma("unroll") for (int m = 0; m < 4; ++m) _Pragma("unroll") for (int j = 0; j < 4; ++j) { const int jj = (m & 1) ? 3 - j : j, n = jj >> 1, k = (jj & 1) ^ (jj >> 1); \
        acc[ai][bj][m][n] = __builtin_amdgcn_mfma_f32_16x16x32_bf16(Bt[n][k], At[m][k], acc[ai][bj][m][n], 0, 0, 0); if (j & 1) __builtin_amdgcn_sched_barrier(0); } } while (0)
#define PG8_MMA2(ai, At, B0_, B1_) do { __builtin_amdgcn_s_setprio(1); PG8_MMA_NP(ai, 0, At, B0_); PG8_MMA_NP(ai, 1, At, B1_); __builtin_amdgcn_s_setprio(0); } while (0)
#define PG8_WAIT_V(n) asm volatile("s_waitcnt vmcnt(" #n ")" ::: "memory")
#define PG8_WAIT_L(n) asm volatile("s_waitcnt lgkmcnt(" #n ")" ::: "memory")
#define PG8_BAR __builtin_amdgcn_s_barrier()
#define PG8_SCHED __builtin_amdgcn_sched_barrier(0)
    Unit cur, nxt; int ui = 0;
    if (!S.next(0, cur)) return;
    f32x4 acc[2][2][4][2];
#pragma unroll
    for (int a = 0; a < 2; ++a)
#pragma unroll
        for (int b = 0; b < 2; ++b)
#pragma unroll
            for (int m = 0; m < 4; ++m)
#pragma unroll
                for (int n = 0; n < 2; ++n) acc[a][b][m][n] = (f32x4){0.f, 0.f, 0.f, 0.f};
    bf16x8 At[4][2], B0[2][2], B1[2][2];
    const char* cA = (const char*)g.A + (size_t)cur.pm * tstep + (size_t)cur.kt0 * kstep; const char* cB = (const char*)g.Bt + (size_t)cur.pn * tstep + (size_t)cur.kt0 * kstep;
    S.a_ready(cur);
    if constexpr (SP2) {
        PG8_STAGE(PG8_SB(0, 0), cB, voffB); PG8_STAGE(PG8_SB(0, 1), cB + hstep, voffB); PG8_STAGE(PG8_SA(0, 0), cA, voffA); PG8_STAGE(PG8_SA(0, 1), cA + hstep, voffA);
        if (wr == 1) PG8_BAR;
        PG8_WAIT_V(2); PG8_BAR;
        PG8_STAGE(PG8_SB(1, 0), cB + kstep, voffB); PG8_STAGE(PG8_SA(1, 0), cA + kstep, voffA); PG8_STAGE(PG8_SB(1, 1), cB + hstep + kstep, voffB);
        PG8_WAIT_V(6); PG8_BAR;
    } else {
        PG8_STAGE(PG8_SB(0, 0), cB, voffB); PG8_STAGE(PG8_SA(0, 0), cA, voffA); PG8_STAGE(PG8_SB(0, 1), cB + hstep, voffB); PG8_STAGE(PG8_SA(0, 1), cA + hstep, voffA);
        if (wr == 1) PG8_BAR;
        PG8_WAIT_V(4); PG8_BAR;
        PG8_STAGE(PG8_SB(1, 0), cB + kstep, voffB); PG8_STAGE(PG8_SA(1, 0), cA + kstep, voffA); PG8_STAGE(PG8_SB(1, 1), cB + hstep + kstep, voffB);
        PG8_WAIT_V(6); PG8_BAR;
    }
    for (;;) {
        const bool has_next = S.next(ui + 1, nxt);
        const char* nA = has_next ? (const char*)g.A + (size_t)nxt.pm * tstep + (size_t)nxt.kt0 * kstep : cA; const char* nB = has_next ? (const char*)g.Bt + (size_t)nxt.pn * tstep + (size_t)nxt.kt0 * kstep : cB;
        const int nt = cur.nkt;
        for (int t = 0; t < nt; t += 2) {
            const bool last = (t == nt - 2);
            const char* a1 = cA + (size_t)(t + 1) * kstep;
            const char* a2 = last ? nA : cA + (size_t)(t + 2) * kstep; const char* b2 = last ? nB : cB + (size_t)(t + 2) * kstep;
            const char* a3 = a2 + kstep; const char* b3 = b2 + kstep;
            if (last && has_next) S.a_ready(nxt);
            if constexpr (SP2) {
            PG8_LDB(B0, 0, 0); PG8_LDB(B1, 0, 1); PG8_SCHED; PG8_LDA(At, 0, 0); PG8_STAGE(PG8_SA(1, 1), a1 + hstep, voffA);
            PG8_WAIT_V(8); PG8_WAIT_L(0); PG8_BAR; PG8_MMA2(0, At, B0, B1); PG8_BAR; PG8_SCHED;
            PG8_LDA(At, 0, 1); PG8_STAGE(PG8_SB(0, 0), b2, voffB); PG8_STAGE(PG8_SB(0, 1), b2 + hstep, voffB); PG8_STAGE(PG8_SA(0, 0), a2, voffA);
            PG8_WAIT_V(8); PG8_WAIT_L(0); PG8_BAR; PG8_MMA2(1, At, B0, B1); PG8_BAR; PG8_SCHED;
            PG8_LDB(B0, 1, 0); PG8_LDB(B1, 1, 1); PG8_SCHED; PG8_LDA(At, 1, 0); PG8_STAGE(PG8_SA(0, 1), a2 + hstep, voffA);
            PG8_WAIT_V(8); PG8_WAIT_L(0); PG8_BAR; PG8_MMA2(0, At, B0, B1); PG8_BAR; PG8_SCHED;
            PG8_LDA(At, 1, 1); PG8_STAGE(PG8_SB(1, 0), b3, voffB); PG8_STAGE(PG8_SB(1, 1), b3 + hstep, voffB); PG8_STAGE(PG8_SA(1, 0), a3, voffA);
            PG8_WAIT_V(8); PG8_WAIT_L(0); PG8_BAR; PG8_MMA2(1, At, B0, B1); PG8_BAR; PG8_SCHED;
            } else {
            PG8_LDB(B0, 0, 0); PG8_SCHED; PG8_LDA(At, 0, 0); PG8_STAGE(PG8_SA(1, 1), a1 + hstep, voffA);
            PG8_WAIT_L(8); PG8_BAR; PG8_WAIT_L(0); PG8_MMA(0, 0, At, B0); PG8_BAR; PG8_SCHED;
            PG8_LDB(B1, 0, 1); PG8_STAGE(PG8_SB(0, 0), b2, voffB);
            PG8_BAR; PG8_WAIT_L(0); PG8_MMA(0, 1, At, B1); PG8_BAR;
            PG8_LDA(At, 0, 1); PG8_STAGE(PG8_SA(0, 0), a2, voffA);
            PG8_BAR; PG8_WAIT_L(0); PG8_MMA(1, 0, At, B0); PG8_BAR; PG8_SCHED;
            PG8_STAGE(PG8_SB(0, 1), b2 + hstep, voffB);
            PG8_WAIT_V(6); PG8_BAR; PG8_MMA(1, 1, At, B1); PG8_BAR;
            PG8_LDB(B0, 1, 0); PG8_SCHED; PG8_LDA(At, 1, 0); PG8_STAGE(PG8_SA(0, 1), a2 + hstep, voffA);
            PG8_WAIT_L(8); PG8_BAR; PG8_WAIT_L(0); PG8_MMA(0, 0, At, B0); PG8_BAR; PG8_SCHED;
            PG8_LDB(B1, 1, 1); PG8_STAGE(PG8_SB(1, 0), b3, voffB);
            PG8_BAR; PG8_WAIT_L(0); PG8_MMA(0, 1, At, B1); PG8_BAR;
            PG8_LDA(At, 1, 1); PG8_STAGE(PG8_SA(1, 0), a3, voffA);
            PG8_BAR; PG8_WAIT_L(0); PG8_MMA(1, 0, At, B0); PG8_BAR; PG8_SCHED;
            PG8_STAGE(PG8_SB(1, 1), b3 + hstep, voffB);
            PG8_WAIT_V(6); PG8_BAR; PG8_MMA(1, 1, At, B1); PG8_BAR;
            }
        }
        if constexpr (ALIGN_EPI) { if (wr == 0) PG8_BAR; }
        if constexpr (!Epi::AFTER_DRAIN) { E(acc, cur, wr, wc, fr, fq); S.done(cur); }
        if (!has_next) break;
#pragma unroll
        for (int a = 0; a < 2; ++a)
#pragma unroll
            for (int b = 0; b < 2; ++b)
#pragma unroll
                for (int m = 0; m < 4; ++m)
#pragma unroll
                    for (int n = 0; n < 2; ++n) acc[a][b][m][n] = (f32x4){0.f, 0.f, 0.f, 0.f};
        cur = nxt; cA = nA; cB = nB; ++ui;
        if constexpr (ALIGN_EPI) { if (wr == 1) PG8_BAR; }
    }
    PG8_WAIT_V(0);
    if constexpr (!ALIGN_EPI) { if (wr == 0) PG8_BAR; }
    PG8_BAR;
    if constexpr (Epi::AFTER_DRAIN) { E.fused(acc, cur, wr, wc, fr, fq, lds, wid, lane); S.done(cur); }
#undef PG8_SA
#undef PG8_SB
#undef PG8_STAGE
#undef PG8_LDA
#undef PG8_LDB
#undef PG8_MMA
#undef PG8_WAIT_V
#undef PG8_WAIT_L
#undef PG8_BAR
#undef PG8_SCHED
}
}

namespace attn {
using bf16 = __hip_bfloat16;
constexpr int   D = 128, NW = 8, QBLK = 32, KVBLK = 64, HQ = 32, HKV = 8;
constexpr float SCALE = 0.088388347648318440f;
constexpr float THR = 8.f;
constexpr int SDEPTH = 2;
constexpr int LDQ = HQ * D, LDK = HKV * D, LDO = LDQ;
constexpr size_t SHM_V = KVBLK * D * 2, SHM_K = KVBLK * D * 2, SHM_ATTN = 4 * SHM_V + 3 * SHM_K + NW * 64 * 4;
using bf16x8 = __attribute__((ext_vector_type(8))) short;
using s16x4  = __attribute__((ext_vector_type(4))) short;
using f32x16 = __attribute__((ext_vector_type(16))) float;
using f32x8  = __attribute__((ext_vector_type(8))) float;
using f32x2  = __attribute__((ext_vector_type(2))) float;
using u32x4  = __attribute__((ext_vector_type(4))) unsigned;
#define KSWZ(row, colB) ((row) * 256 + ((colB) ^ (((row) & 15) << 4)))
#define SBAR() __builtin_amdgcn_sched_barrier(0)
__device__ __forceinline__ int crow(int r, int hi) { return (r & 3) + 8 * (r >> 2) + 4 * hi; }
__device__ __forceinline__ unsigned cvtpk(float lo, float hi) {
  unsigned r; asm volatile("v_cvt_pk_bf16_f32 %0, %1, %2" : "=v"(r) : "v"(lo), "v"(hi)); return r;
}
template <typename TIn> struct Stage;
template <> struct Stage<bf16>  { using T = bf16x8;
  __device__ static __forceinline__ T ld8(const bf16* p) { return *reinterpret_cast<const bf16x8*>(p); }
  __device__ static __forceinline__ bf16x8 tobf(T x) { return x; } };
template <> struct Stage<float> { using T = f32x8;
  __device__ static __forceinline__ T ld8(const float* p) { return *reinterpret_cast<const f32x8*>(p); }
  __device__ static __forceinline__ bf16x8 tobf(T x) {
    u32x4 w = {cvtpk(x[0], x[1]), cvtpk(x[2], x[3]), cvtpk(x[4], x[5]), cvtpk(x[6], x[7])}; return *reinterpret_cast<bf16x8*>(&w); } };

__device__ __forceinline__ void partialSM(f32x16& p0, f32x16& p1, float& m_reg, float& mn, float& alpha) {
  constexpr float C = SCALE * 1.4426950408889634f;
  float pmax = p0[0]; for (int r = 1; r < 16; ++r) pmax = fmaxf(pmax, p0[r]); for (int r = 0; r < 16; ++r) pmax = fmaxf(pmax, p1[r]);
  { auto rr = __builtin_amdgcn_permlane32_swap(__float_as_uint(pmax), __float_as_uint(pmax), false, false);
    pmax = fmaxf(__uint_as_float(rr[0]), __uint_as_float(rr[1])); }
  if (__builtin_expect(__all(pmax - m_reg <= THR / SCALE), 1)) { mn = m_reg; alpha = 1.f; }
  else { mn = fmaxf(m_reg, pmax); alpha = __builtin_amdgcn_exp2f((m_reg - mn) * C); m_reg = mn; }
  float mnC = -mn * C;
  for (int r = 0; r < 16; ++r) p0[r] = fmaf(p0[r], C, mnC); for (int r = 0; r < 16; ++r) p1[r] = fmaf(p1[r], C, mnC);
  for (int r = 0; r < 16; ++r) p0[r] = __builtin_amdgcn_exp2f(p0[r]);
}
__device__ __forceinline__ void finishSM(f32x16& p0, f32x16& p1, float alpha, float& l_reg, bf16x8& pa0, bf16x8& pa1, bf16x8& pa2, bf16x8& pa3) {
  for (int r = 0; r < 16; ++r) p1[r] = __builtin_amdgcn_exp2f(p1[r]);
  float ps = 0; for (int r = 0; r < 16; ++r) ps += p0[r]; for (int r = 0; r < 16; ++r) ps += p1[r];
  { auto rr = __builtin_amdgcn_permlane32_swap(__float_as_uint(ps), __float_as_uint(ps), false, false);
    ps = __uint_as_float(rr[0]) + __uint_as_float(rr[1]); }
  l_reg = l_reg * alpha + ps;
#define PK4(P, BASE, OUT) do { unsigned a0 = cvtpk(P[BASE + 0], P[BASE + 1]), a1 = cvtpk(P[BASE + 2], P[BASE + 3]);   \
    unsigned b0 = cvtpk(P[BASE + 4], P[BASE + 5]), b1 = cvtpk(P[BASE + 6], P[BASE + 7]);                              \
    auto r0 = __builtin_amdgcn_permlane32_swap(a0, b0, false, false); auto r1 = __builtin_amdgcn_permlane32_swap(a1, b1, false, false); \
    u32x4 w = {r0[0], r1[0], r0[1], r1[1]}; OUT = *reinterpret_cast<bf16x8*>(&w); } while (0)
  PK4(p0, 0, pa0); PK4(p0, 8, pa1); PK4(p1, 0, pa2); PK4(p1, 8, pa3);
#undef PK4
}
__device__ __forceinline__ void partialSM_b(f32x16& p0) {
  for (int r = 0; r < 16; ++r) p0[r] = __builtin_amdgcn_exp2f(p0[r]);
}
__device__ __forceinline__ void finishSM_b(f32x16& p0, f32x16& p1, float& l_reg, bf16x8& pa0, bf16x8& pa1, bf16x8& pa2, bf16x8& pa3) {
  for (int r = 0; r < 16; ++r) p1[r] = __builtin_amdgcn_exp2f(p1[r]);
  float ps = 0; for (int r = 0; r < 16; ++r) ps += p0[r]; for (int r = 0; r < 16; ++r) ps += p1[r];
  { auto rr = __builtin_amdgcn_permlane32_swap(__float_as_uint(ps), __float_as_uint(ps), false, false);
    ps = __uint_as_float(rr[0]) + __uint_as_float(rr[1]); }
  l_reg += ps;
#define PK4(P, BASE, OUT) do { unsigned a0 = cvtpk(P[BASE + 0], P[BASE + 1]), a1 = cvtpk(P[BASE + 2], P[BASE + 3]);   \
    unsigned b0 = cvtpk(P[BASE + 4], P[BASE + 5]), b1 = cvtpk(P[BASE + 6], P[BASE + 7]);                              \
    auto r0 = __builtin_amdgcn_permlane32_swap(a0, b0, false, false); auto r1 = __builtin_amdgcn_permlane32_swap(a1, b1, false, false); \
    u32x4 w = {r0[0], r1[0], r0[1], r1[1]}; OUT = *reinterpret_cast<bf16x8*>(&w); } while (0)
  PK4(p0, 0, pa0); PK4(p0, 8, pa1); PK4(p1, 0, pa2); PK4(p1, 8, pa3);
#undef PK4
}
__device__ __forceinline__ void qkt(f32x16& p0, f32x16& p1, const bf16* Ks, const bf16x8* qr, int r32, int hi) {
  p0 = f32x16{}; p1 = f32x16{};
  for (int d0 = 0; d0 < 8; ++d0) { int cb = (d0 * 16 + hi * 8) * 2;
    bf16x8 b0 = *reinterpret_cast<const bf16x8*>((const char*)Ks + KSWZ(r32, cb));
    bf16x8 b1 = *reinterpret_cast<const bf16x8*>((const char*)Ks + KSWZ(32 + r32, cb));
    p0 = __builtin_amdgcn_mfma_f32_32x32x16_bf16(b0, qr[d0], p0, 0, 0, 0);
    p1 = __builtin_amdgcn_mfma_f32_32x32x16_bf16(b1, qr[d0], p1, 0, 0, 0); }
}
template <int OFF> __device__ __forceinline__ bf16x8 k_read(int ka) { bf16x8 r; asm volatile("ds_read_b128 %0, %1 offset:%2" : "=&v"(r) : "v"(ka), "i"(OFF) : "memory"); return r; }
__device__ __forceinline__ int v_st(int k, int c) { const int kk = (k & ~0xC) | ((k & 4) << 1) | ((k & 8) >> 1); return ((kk >> 3) * 4 + (c >> 5)) * 512 + ((kk & 7) * 32 + (c & 31)) * 2; }
__device__ __forceinline__ int v_rd_base(int lane) { return ((lane & 3) << 3) | (((lane >> 2) & 3) << 6) | (((lane >> 4) & 1) << 5) | (((lane >> 5) & 1) << 8); }
constexpr int v_rd_off(int d0, int ks, int half) { return d0 * 512 + ks * 4096 + half * 2048; }
template <int OFF> __device__ __forceinline__ s16x4 tr_read(int vb) {
  s16x4 r; asm volatile("ds_read_b64_tr_b16 %0, %1 offset:%2" : "=&v"(r) : "v"(vb), "i"(OFF) : "memory"); return r;
}
struct VFrag { s16x4 l0, h0, l1, h1, l2, h2, l3, h3; };
template <int D0> __device__ __forceinline__ void v_load(VFrag& f, int vb) {
  f.l0 = tr_read<v_rd_off(D0, 0, 0)>(vb); f.h0 = tr_read<v_rd_off(D0, 0, 1)>(vb); f.l1 = tr_read<v_rd_off(D0, 1, 0)>(vb); f.h1 = tr_read<v_rd_off(D0, 1, 1)>(vb);
  f.l2 = tr_read<v_rd_off(D0, 2, 0)>(vb); f.h2 = tr_read<v_rd_off(D0, 2, 1)>(vb); f.l3 = tr_read<v_rd_off(D0, 3, 0)>(vb); f.h3 = tr_read<v_rd_off(D0, 3, 1)>(vb);
}
__device__ __forceinline__ void pv_mma(f32x16& od, const VFrag& f, bf16x8 pa0, bf16x8 pa1, bf16x8 pa2, bf16x8 pa3) {
#define PK(L, H) (bf16x8){L[0], L[1], L[2], L[3], H[0], H[1], H[2], H[3]}
  od = __builtin_amdgcn_mfma_f32_32x32x16_bf16(pa0, PK(f.l0, f.h0), od, 0, 0, 0);
  od = __builtin_amdgcn_mfma_f32_32x32x16_bf16(pa1, PK(f.l1, f.h1), od, 0, 0, 0);
  od = __builtin_amdgcn_mfma_f32_32x32x16_bf16(pa2, PK(f.l2, f.h2), od, 0, 0, 0);
  od = __builtin_amdgcn_mfma_f32_32x32x16_bf16(pa3, PK(f.l3, f.h3), od, 0, 0, 0);
#undef PK
}
template <int D0> __device__ __forceinline__ void pv_one(f32x16& od, int vb, bf16x8 pa0, bf16x8 pa1, bf16x8 pa2, bf16x8 pa3) {
  const s16x4 l0 = tr_read<v_rd_off(D0, 0, 0)>(vb), h0 = tr_read<v_rd_off(D0, 0, 1)>(vb), l1 = tr_read<v_rd_off(D0, 1, 0)>(vb), h1 = tr_read<v_rd_off(D0, 1, 1)>(vb);
  const s16x4 l2 = tr_read<v_rd_off(D0, 2, 0)>(vb), h2 = tr_read<v_rd_off(D0, 2, 1)>(vb), l3 = tr_read<v_rd_off(D0, 3, 0)>(vb), h3 = tr_read<v_rd_off(D0, 3, 1)>(vb);
  asm volatile("s_waitcnt lgkmcnt(0)" ::: "memory"); SBAR();
#define PK(L, H) (bf16x8){L[0], L[1], L[2], L[3], H[0], H[1], H[2], H[3]}
  od = __builtin_amdgcn_mfma_f32_32x32x16_bf16(pa0, PK(l0, h0), od, 0, 0, 0);
  od = __builtin_amdgcn_mfma_f32_32x32x16_bf16(pa1, PK(l1, h1), od, 0, 0, 0);
  od = __builtin_amdgcn_mfma_f32_32x32x16_bf16(pa2, PK(l2, h2), od, 0, 0, 0);
  od = __builtin_amdgcn_mfma_f32_32x32x16_bf16(pa3, PK(l3, h3), od, 0, 0, 0);
#undef PK
}
template <bool PIPE> __device__ __forceinline__ void pv_d0(f32x16* o, int vb, bf16x8 pa0, bf16x8 pa1, bf16x8 pa2, bf16x8 pa3) {
  if constexpr (!PIPE) { pv_one<0>(o[0], vb, pa0, pa1, pa2, pa3); pv_one<1>(o[1], vb, pa0, pa1, pa2, pa3); pv_one<2>(o[2], vb, pa0, pa1, pa2, pa3); pv_one<3>(o[3], vb, pa0, pa1, pa2, pa3); return; }
  VFrag A, B;
  v_load<0>(A, vb); v_load<1>(B, vb);
  asm volatile("s_waitcnt lgkmcnt(8)" ::: "memory"); SBAR(); pv_mma(o[0], A, pa0, pa1, pa2, pa3); SBAR();
  v_load<2>(A, vb);
  asm volatile("s_waitcnt lgkmcnt(8)" ::: "memory"); SBAR(); pv_mma(o[1], B, pa0, pa1, pa2, pa3); SBAR();
  v_load<3>(B, vb);
  asm volatile("s_waitcnt lgkmcnt(8)" ::: "memory"); SBAR(); pv_mma(o[2], A, pa0, pa1, pa2, pa3); SBAR();
  asm volatile("s_waitcnt lgkmcnt(0)" ::: "memory"); SBAR(); pv_mma(o[3], B, pa0, pa1, pa2, pa3);
}

template <typename TQ, bool BOUNDED>
__device__ __forceinline__ void attn_dense_body(const TQ* __restrict__ Qb, const bf16* __restrict__ Kh, const bf16* __restrict__ Vh,
                                                bf16* __restrict__ Ob, int seq, char* lds, const float* __restrict__ q_gain, const float* __restrict__ rope, int t0) {
  using St = Stage<bf16>; using SQ = Stage<TQ>;
  constexpr int SD = BOUNDED ? 1 : 2;
  int tid_ = threadIdx.x; asm volatile("" : "+v"(tid_));
  const int tid = tid_, wid = tid >> 6, lane = tid & 63, r32 = lane & 31, hi = lane >> 5;
  bf16* V_lds = (bf16*)lds; bf16* K_lds = (bf16*)(lds + 2 * SHM_V);
  float* ws = (float*)(lds + 2 * SHM_V + 2 * SHM_K) + wid * 64; float* li_l = ws; float* al_l = ws + 32;
  float m_reg = -1e30f, l_reg = 0; f32x16 o[4] = {}; bf16x8 qr[8];
  const TQ* Qw = Qb + (long)(wid * QBLK + r32) * LDQ + hi * 8;
#pragma unroll
  for (int d0 = 0; d0 < 8; ++d0) qr[d0] = SQ::tobf(SQ::ld8(Qw + d0 * 16));
  const int sr = tid >> 4, sc = (tid & 15) * 8, vst0 = v_st(sr, sc), vst1 = v_st(32 + sr, sc);
  const int vb0 = (int)(uintptr_t)V_lds + v_rd_base(lane);
  struct { typename St::T vs0, vs1, ks0, ks1; } sr_[SD];
#define SLOAD(i, k0) do { sr_[i].vs0 = St::ld8(&Vh[(long)((k0) + sr) * LDK + sc]); sr_[i].vs1 = St::ld8(&Vh[(long)((k0) + 32 + sr) * LDK + sc]); \
    sr_[i].ks0 = St::ld8(&Kh[(long)((k0) + sr) * LDK + sc]); sr_[i].ks1 = St::ld8(&Kh[(long)((k0) + 32 + sr) * LDK + sc]); } while (0)
#define SWRITE(b, i) do { *(bf16x8*)((char*)V_lds + (b) * SHM_V + vst0) = St::tobf(sr_[i].vs0);          \
    *(bf16x8*)((char*)V_lds + (b) * SHM_V + vst1) = St::tobf(sr_[i].vs1); int kc = sc * 2;               \
    *(bf16x8*)((char*)K_lds + (b) * SHM_K + KSWZ(sr, kc)) = St::tobf(sr_[i].ks0);                       \
    *(bf16x8*)((char*)K_lds + (b) * SHM_K + KSWZ(32 + sr, kc)) = St::tobf(sr_[i].ks1); } while (0)
#define SWAIT() do { if constexpr (SD == 2) asm volatile("s_waitcnt vmcnt(4)" ::: "memory"); else asm volatile("s_waitcnt vmcnt(0)" ::: "memory"); } while (0)
#define PSM(P0, P1, MN, AL) do { if constexpr (BOUNDED) partialSM_b(P0); else partialSM(P0, P1, m_reg, MN, AL); } while (0)
#define FSM(P0, P1, AL) do { if constexpr (BOUNDED) finishSM_b(P0, P1, l_reg, pa0, pa1, pa2, pa3); else finishSM(P0, P1, AL, l_reg, pa0, pa1, pa2, pa3); } while (0)
#define RESC(a) do { if constexpr (!BOUNDED) if (__any((a) < 1.f)) { if (hi == 0) al_l[r32] = (a); asm volatile("s_waitcnt lgkmcnt(0)" ::: "memory"); \
    for (int d = 0; d < 4; ++d) for (int r = 0; r < 16; ++r) o[d][r] *= al_l[crow(r, hi)]; } } while (0)
  f32x16 pA0, pA1, pB0, pB1; float mnA = 0.f, mnB = 0.f, alA = 1.f, alB = 1.f; bf16x8 pa0, pa1, pa2, pa3; const int NT = seq / KVBLK;
  constexpr int SE = 0, SO = SD - 1;
  SLOAD(SE, 0);
  { const int t = t0 + wid * QBLK + r32; float ss = 0.f;
#pragma unroll
    for (int d0 = 0; d0 < 8; ++d0)
#pragma unroll
      for (int j = 0; j < 8; ++j) { const float x = __uint_as_float(((unsigned)(unsigned short)qr[d0][j]) << 16); ss += x * x; }
    ss += __shfl_xor(ss, 32);
    const float rs = (1.f / sqrtf(ss * (1.f / D) + 1e-6f)) * (BOUNDED ? SCALE * 1.4426950408889634f : 1.0f);
#pragma unroll
    for (int a = 0; a < 2; ++a) { const int pos = a ? (t & 63) : (t >> 6);
#pragma unroll
      for (int e = 0; e < 2; ++e) { const int dA = 4 * a + e, dB = dA + 2;
        const float* cs = rope + (size_t)(pos * 32 + e * 16 + hi * 8) * 2; const float* gA = q_gain + dA * 16 + hi * 8; const float* gB = q_gain + dB * 16 + hi * 8;
        float oA[8], oB[8];
#pragma unroll
        for (int j = 0; j < 8; ++j) { const float xa = __uint_as_float(((unsigned)(unsigned short)qr[dA][j]) << 16) * rs * gA[j], xb = __uint_as_float(((unsigned)(unsigned short)qr[dB][j]) << 16) * rs * gB[j];
          const float c = cs[2 * j], sn = cs[2 * j + 1]; oA[j] = xa * c - xb * sn; oB[j] = xb * c + xa * sn; }
        u32x4 wA = {cvtpk(oA[0], oA[1]), cvtpk(oA[2], oA[3]), cvtpk(oA[4], oA[5]), cvtpk(oA[6], oA[7])}, wB = {cvtpk(oB[0], oB[1]), cvtpk(oB[2], oB[3]), cvtpk(oB[4], oB[5]), cvtpk(oB[6], oB[7])};
        qr[dA] = *reinterpret_cast<bf16x8*>(&wA); qr[dB] = *reinterpret_cast<bf16x8*>(&wB); } } }
  asm volatile("s_waitcnt vmcnt(0)" ::: "memory"); SWRITE(0, SE); __syncthreads();
  qkt(pA0, pA1, K_lds, qr, r32, hi); PSM(pA0, pA1, mnA, alA);
  SLOAD(SO, KVBLK); if constexpr (SD == 2) { if (2 < NT) SLOAD(SE, 2 * KVBLK); }
  SWAIT(); SWRITE(1, SO); __syncthreads();
  for (int j = 1; j + 1 < NT; j += 2) {
    SBAR(); qkt(pB0, pB1, (bf16*)((char*)K_lds + SHM_K), qr, r32, hi);
    FSM(pA0, pA1, alA); SBAR();
    SLOAD(SO, (j + SD) * KVBLK); SBAR();
    pv_d0<BOUNDED>(o, vb0, pa0, pa1, pa2, pa3); PSM(pB0, pB1, mnB, alB);
    __syncthreads(); SWAIT(); SWRITE(0, SE);
    RESC(alB); __syncthreads();
    SBAR(); qkt(pA0, pA1, K_lds, qr, r32, hi);
    FSM(pB0, pB1, alB); SBAR();
    if (SD == 1 || j + 3 < NT) SLOAD(SE, (j + 1 + SD) * KVBLK); SBAR();
    pv_d0<BOUNDED>(o, vb0 + (int)SHM_V, pa0, pa1, pa2, pa3); PSM(pA0, pA1, mnA, alA);
    __syncthreads(); SWAIT(); SWRITE(1, SO);
    RESC(alA); __syncthreads();
  }
  SBAR(); qkt(pB0, pB1, (bf16*)((char*)K_lds + SHM_K), qr, r32, hi);
  FSM(pA0, pA1, alA); SBAR();
  pv_d0<BOUNDED>(o, vb0, pa0, pa1, pa2, pa3); PSM(pB0, pB1, mnB, alB);
  __syncthreads(); RESC(alB);
  FSM(pB0, pB1, alB); SBAR();
  pv_d0<BOUNDED>(o, vb0 + (int)SHM_V, pa0, pa1, pa2, pa3);
  if (hi == 0) li_l[r32] = l_reg; asm volatile("s_waitcnt lgkmcnt(0)" ::: "memory");
  float rli[16];
#pragma unroll
  for (int r = 0; r < 16; ++r) rli[r] = __builtin_amdgcn_rcpf(li_l[crow(r, hi)]);
  __syncthreads();
  { int ln_ = (int)__builtin_amdgcn_mbcnt_hi(~0u, __builtin_amdgcn_mbcnt_lo(~0u, 0u)); asm volatile("" : "+v"(ln_));
    const int hi_ = ln_ >> 5, r32_ = ln_ & 31;
    char* wbase = lds + wid * 8192 + hi_ * 1024 + r32_ * 2;
#pragma unroll
    for (int r = 0; r < 16; ++r)
#pragma unroll
      for (int d0 = 0; d0 < 4; ++d0) *(unsigned short*)(wbase + ((r & 3) + 8 * (r >> 2)) * 256 + d0 * 64) = (unsigned short)(cvtpk(o[d0][r] * rli[r], 0.f) & 0xffffu);
    asm volatile("s_waitcnt lgkmcnt(0)" ::: "memory");
    const char* rbase = lds + wid * 8192 + (ln_ >> 4) * 256 + (ln_ & 15) * 16;
    unsigned short* Ow = (unsigned short*)Ob + (long)(wid * QBLK + (ln_ >> 4)) * LDO + (ln_ & 15) * 8;
#pragma unroll
    for (int j = 0; j < 8; ++j) *(u32x4*)(Ow + (long)(4 * j) * LDO) = *(const u32x4*)(rbase + j * 1024); }
#undef SLOAD
#undef SWRITE
#undef SWAIT
#undef RESC
#undef PSM
#undef FSM
}


using f32x4 = __attribute__((ext_vector_type(4))) float;
#define MF16(a, b, c) __builtin_amdgcn_mfma_f32_16x16x32_bf16(a, b, c, 0, 0, 0)
struct ST16 { f32x4 s[2][4]; };
struct KF16 { bf16x8 d0, d1, d2, d3; };
struct VF16 { s16x4 a0, a1, b0, b1; };
template <int OFF> __device__ __forceinline__ void kf_load(KF16& f, const int (&ka)[4]) { f.d0 = k_read<OFF>(ka[0]); f.d1 = k_read<OFF>(ka[1]); f.d2 = k_read<OFF>(ka[2]); f.d3 = k_read<OFF>(ka[3]); }
template <int OFF> __device__ __forceinline__ void vf_load(VF16& f, int vb) { f.a0 = tr_read<OFF>(vb); f.a1 = tr_read<OFF + 4096>(vb); f.b0 = tr_read<OFF + 8192>(vb); f.b1 = tr_read<OFF + 12288>(vb); }
__device__ __forceinline__ void qk_mma16(f32x4& s0, f32x4& s1, const KF16& f, const bf16x8 (&qr)[2][4]) {
  s0 = MF16(f.d0, qr[0][0], s0); s1 = MF16(f.d0, qr[1][0], s1); s0 = MF16(f.d1, qr[0][1], s0); s1 = MF16(f.d1, qr[1][1], s1);
  s0 = MF16(f.d2, qr[0][2], s0); s1 = MF16(f.d2, qr[1][2], s1); s0 = MF16(f.d3, qr[0][3], s0); s1 = MF16(f.d3, qr[1][3], s1);
}
__device__ __forceinline__ void pv_mma16(f32x4& o0, f32x4& o1, const VF16& f, const bf16x8 (&pa)[2][2]) {
#define PK(L, H) (bf16x8){L[0], L[1], L[2], L[3], H[0], H[1], H[2], H[3]}
  const bf16x8 v0 = PK(f.a0, f.a1), v1 = PK(f.b0, f.b1);
  o0 = MF16(pa[0][0], v0, o0); o1 = MF16(pa[1][0], v0, o1); o0 = MF16(pa[0][1], v1, o0); o1 = MF16(pa[1][1], v1, o1);
#undef PK
}
__device__ __forceinline__ bf16x8 pack2_16(const f32x4& a, const f32x4& b) { u32x4 w = {cvtpk(a[0], a[1]), cvtpk(a[2], a[3]), cvtpk(b[0], b[1]), cvtpk(b[2], b[3])}; return *reinterpret_cast<bf16x8*>(&w); }
__device__ __forceinline__ void acc_l16(f32x2& l, const f32x4& a) { l += (f32x2){a[0], a[1]}; l += (f32x2){a[2], a[3]}; }
__device__ __forceinline__ void exp4_16(f32x4& a) { a[0] = __builtin_amdgcn_exp2f(a[0]); a[1] = __builtin_amdgcn_exp2f(a[1]); a[2] = __builtin_amdgcn_exp2f(a[2]); a[3] = __builtin_amdgcn_exp2f(a[3]); }
template <int G> __device__ __forceinline__ void fsm16(ST16& T, f32x2 (&l2)[2], bf16x8 (&pa)[2][2]) {
  if constexpr (G == 0) { pa[0][0] = pack2_16(T.s[0][0], T.s[0][1]); acc_l16(l2[0], T.s[0][0]); acc_l16(l2[0], T.s[0][1]); }
  else if constexpr (G == 1) { pa[1][0] = pack2_16(T.s[1][0], T.s[1][1]); acc_l16(l2[1], T.s[1][0]); acc_l16(l2[1], T.s[1][1]); }
  else if constexpr (G == 2) { pa[0][1] = pack2_16(T.s[0][2], T.s[0][3]); acc_l16(l2[0], T.s[0][2]); acc_l16(l2[0], T.s[0][3]); }
  else { pa[1][1] = pack2_16(T.s[1][2], T.s[1][3]); acc_l16(l2[1], T.s[1][2]); acc_l16(l2[1], T.s[1][3]); }
}
template <int KOFF, bool FSM, bool DMA> __device__ __forceinline__ void qk16(ST16& C, const int (&ka)[4], const bf16x8 (&qr)[2][4], ST16& P, f32x2 (&l2)[2], bf16x8 (&pa)[2][2],
                                                                          const bf16* kp, const bf16* vp, PG8_LAS unsigned char* dKb, PG8_LAS unsigned char* dVb) {
#define GLDS4(src, dst) __builtin_amdgcn_global_load_lds((const unsigned*)(src), (PG8_LAS unsigned*)(dst), 16, 0, 0)
  KF16 fa, fb;
#pragma unroll
  for (int qb = 0; qb < 2; ++qb)
#pragma unroll
    for (int kb = 0; kb < 4; ++kb) C.s[qb][kb] = (f32x4){0.f, 0.f, 0.f, 0.f};
  kf_load<KOFF>(fa, ka); kf_load<KOFF + 4096>(fb, ka);
  asm volatile("s_waitcnt lgkmcnt(4)" ::: "memory"); SBAR(); qk_mma16(C.s[0][0], C.s[1][0], fa, qr); if constexpr (FSM) fsm16<0>(P, l2, pa); kf_load<KOFF + 8192>(fa, ka); if constexpr (DMA) GLDS4(kp, dKb);
  asm volatile("s_waitcnt lgkmcnt(4)" ::: "memory"); SBAR(); qk_mma16(C.s[0][1], C.s[1][1], fb, qr); if constexpr (FSM) fsm16<1>(P, l2, pa); kf_load<KOFF + 12288>(fb, ka); if constexpr (DMA) GLDS4(kp + 32 * LDK, dKb + 8192);
  asm volatile("s_waitcnt lgkmcnt(4)" ::: "memory"); SBAR(); qk_mma16(C.s[0][2], C.s[1][2], fa, qr); if constexpr (FSM) fsm16<2>(P, l2, pa); if constexpr (DMA) GLDS4(vp, dVb);
  asm volatile("s_waitcnt lgkmcnt(0)" ::: "memory"); SBAR(); qk_mma16(C.s[0][3], C.s[1][3], fb, qr); if constexpr (FSM) fsm16<3>(P, l2, pa); if constexpr (DMA) GLDS4(vp + 32 * LDK, dVb + 8192);
#undef GLDS4
}
template <int VOFF, bool PEX> __device__ __forceinline__ void pv16(f32x4 (&o)[2][8], int vb, const bf16x8 (&pa)[2][2], ST16& C) {
  VF16 A0, A1, B0, B1;
  vf_load<VOFF>(A0, vb); vf_load<VOFF + 256>(A1, vb); vf_load<VOFF + 512>(B0, vb); vf_load<VOFF + 768>(B1, vb);
  asm volatile("s_waitcnt lgkmcnt(8)" ::: "memory"); SBAR(); pv_mma16(o[0][0], o[1][0], A0, pa); pv_mma16(o[0][1], o[1][1], A1, pa); if constexpr (PEX) { exp4_16(C.s[0][0]); exp4_16(C.s[1][0]); }
  vf_load<VOFF + 1024>(A0, vb); vf_load<VOFF + 1280>(A1, vb);
  asm volatile("s_waitcnt lgkmcnt(8)" ::: "memory"); SBAR(); pv_mma16(o[0][2], o[1][2], B0, pa); pv_mma16(o[0][3], o[1][3], B1, pa); if constexpr (PEX) { exp4_16(C.s[0][1]); exp4_16(C.s[1][1]); }
  vf_load<VOFF + 1536>(B0, vb); vf_load<VOFF + 1792>(B1, vb);
  asm volatile("s_waitcnt lgkmcnt(8)" ::: "memory"); SBAR(); pv_mma16(o[0][4], o[1][4], A0, pa); pv_mma16(o[0][5], o[1][5], A1, pa); if constexpr (PEX) { exp4_16(C.s[0][2]); exp4_16(C.s[1][2]); }
  asm volatile("s_waitcnt lgkmcnt(0)" ::: "memory"); SBAR(); pv_mma16(o[0][6], o[1][6], B0, pa); pv_mma16(o[0][7], o[1][7], B1, pa); if constexpr (PEX) { exp4_16(C.s[0][3]); exp4_16(C.s[1][3]); }
}
__device__ __forceinline__ void attn_body_c16(const bf16* __restrict__ Qb, const bf16* __restrict__ Kh, const bf16* __restrict__ Vh, bf16* __restrict__ Ob, char* lds, PG8_LAS unsigned char* ldsl,
                                              const float* __restrict__ q_gain, const float* __restrict__ rope, int t0) {
  using St = Stage<bf16>;
  int tid_ = threadIdx.x; asm volatile("" : "+v"(tid_));
  const int tid = tid_, wid = tid >> 6, lane = tid & 63, i16 = lane & 15, g = lane >> 4;
  bf16* V_lds = (bf16*)lds; bf16* K_lds = (bf16*)(lds + 4 * SHM_V);
  float* li_l = (float*)(lds + 4 * SHM_V + 3 * SHM_K) + wid * 64;
  f32x2 l2[2] = {{0.f, 0.f}, {0.f, 0.f}}; f32x4 o[2][8]; bf16x8 qr[2][4];
#pragma unroll
  for (int qb = 0; qb < 2; ++qb)
#pragma unroll
    for (int db = 0; db < 8; ++db) o[qb][db] = (f32x4){0.f, 0.f, 0.f, 0.f};
#pragma unroll
  for (int qb = 0; qb < 2; ++qb)
#pragma unroll
    for (int dc = 0; dc < 4; ++dc) qr[qb][dc] = St::ld8(Qb + (long)(wid * QBLK + qb * 16 + i16) * LDQ + dc * 32 + g * 8);
  int ka[4];
#pragma unroll
  for (int dc = 0; dc < 4; ++dc) ka[dc] = (int)(uintptr_t)K_lds + i16 * 256 + (((dc * 4 + g) ^ i16) << 4);
  const int vb0 = (int)(uintptr_t)V_lds + (g >> 1) * 2048 + (g & 1) * 128 + (i16 >> 2) * 32 + (i16 & 3) * 8;
  const int wu = __builtin_amdgcn_readfirstlane(wid);
  const int krow = 4 * wid + (lane >> 4);
  const unsigned koff = (unsigned)(krow * LDK + (((lane & 15) ^ (krow & 15)) << 3));
  const unsigned voff = (unsigned)(((wid >> 1) * 8 + ((lane >> 1) & 7)) * LDK + ((wid & 1) * 4 + (lane >> 4)) * 16 + (lane & 1) * 8);
  PG8_LAS unsigned char* const dV = ldsl + wu * 1024; PG8_LAS unsigned char* const dK = ldsl + 4 * SHM_V + wu * 1024;
#define GLDS4(src, dst) __builtin_amdgcn_global_load_lds((const unsigned*)(src), (PG8_LAS unsigned*)(dst), 16, 0, 0)
  const bf16* kp_ = Kh + koff; const bf16* vp_ = Vh + voff;
#define SDMA(kb, vb, ADV) do { GLDS4(kp_, dK + (kb) * SHM_K); GLDS4(kp_ + 32 * LDK, dK + (kb) * SHM_K + 8192); GLDS4(vp_, dV + (vb) * SHM_V); GLDS4(vp_ + 32 * LDK, dV + (vb) * SHM_V + 8192); \
    const int adv_ = (ADV) ? KVBLK * LDK : 0; kp_ += adv_; vp_ += adv_; asm volatile("" : "+v"(kp_), "+v"(vp_)); } while (0)
#define WBAR(n) do { asm volatile("s_waitcnt vmcnt(" #n ") lgkmcnt(0)" ::: "memory"); SBAR(); __builtin_amdgcn_s_barrier(); SBAR(); } while (0)
  ST16 TA, TB; bf16x8 pa[2][2];
  SDMA(0, 0, true);
  { f32x4 gq[2][4], cq[2][2][4];
#pragma unroll
    for (int a = 0; a < 2; ++a) { const float* gA = q_gain + a * 64 + g * 8; gq[a][0] = *(const f32x4*)gA; gq[a][1] = *(const f32x4*)(gA + 4); gq[a][2] = *(const f32x4*)(gA + 32); gq[a][3] = *(const f32x4*)(gA + 36); }
#pragma unroll
    for (int qb = 0; qb < 2; ++qb) { const int t = t0 + wid * QBLK + qb * 16 + i16;
#pragma unroll
      for (int a = 0; a < 2; ++a) { const int pos = a ? (t & 63) : (t >> 6); const float* cs = rope + (size_t)(pos * 32 + g * 8) * 2;
#pragma unroll
        for (int k = 0; k < 4; ++k) cq[qb][a][k] = *(const f32x4*)(cs + 4 * k); } }
#pragma unroll
    for (int qb = 0; qb < 2; ++qb) {
      float ss = 0.f;
#pragma unroll
      for (int dc = 0; dc < 4; ++dc)
#pragma unroll
        for (int j = 0; j < 8; ++j) { const float x = __uint_as_float(((unsigned)(unsigned short)qr[qb][dc][j]) << 16); ss += x * x; }
      ss += __shfl_xor(ss, 16); ss += __shfl_xor(ss, 32);
      const float rs = (1.f / sqrtf(ss * (1.f / D) + 1e-6f)) * (SCALE * 1.4426950408889634f);
#pragma unroll
      for (int a = 0; a < 2; ++a) {
        float oA[8], oB[8];
#pragma unroll
        for (int j = 0; j < 8; ++j) { const float xa = __uint_as_float(((unsigned)(unsigned short)qr[qb][2 * a][j]) << 16) * rs * gq[a][j >> 2][j & 3], xb = __uint_as_float(((unsigned)(unsigned short)qr[qb][2 * a + 1][j]) << 16) * rs * gq[a][2 + (j >> 2)][j & 3];
          const float c = cq[qb][a][j >> 1][2 * (j & 1)], sn = cq[qb][a][j >> 1][2 * (j & 1) + 1]; oA[j] = xa * c - xb * sn; oB[j] = xb * c + xa * sn; }
        u32x4 wA = {cvtpk(oA[0], oA[1]), cvtpk(oA[2], oA[3]), cvtpk(oA[4], oA[5]), cvtpk(oA[6], oA[7])}, wB = {cvtpk(oB[0], oB[1]), cvtpk(oB[2], oB[3]), cvtpk(oB[4], oB[5]), cvtpk(oB[6], oB[7])};
        qr[qb][2 * a] = *reinterpret_cast<bf16x8*>(&wA); qr[qb][2 * a + 1] = *reinterpret_cast<bf16x8*>(&wB); } } }
  SDMA(1, 1, true);
  WBAR(4);
  SDMA(2, 2, true); SBAR();
  qk16<0, false, false>(TA, ka, qr, TB, l2, pa, kp_, vp_, dK, dV);
  exp4_16(TA.s[0][0]); exp4_16(TA.s[0][1]); exp4_16(TA.s[1][0]); exp4_16(TA.s[1][1]); exp4_16(TA.s[0][2]); exp4_16(TA.s[0][3]); exp4_16(TA.s[1][2]); exp4_16(TA.s[1][3]);
  WBAR(4);
#define STEP16(J, T) do { \
    SBAR(); \
    if ((J) & 1) { qk16<(((J) + 1) % 3) * (int)SHM_K, true, true>(TA, ka, qr, TB, l2, pa, kp_, vp_, dK + ((J) % 3) * SHM_K, dV + (((J) + 3) % 4) * SHM_V); } \
    else         { qk16<(((J) + 1) % 3) * (int)SHM_K, true, true>(TB, ka, qr, TA, l2, pa, kp_, vp_, dK + ((J) % 3) * SHM_K, dV + (((J) + 3) % 4) * SHM_V); } \
    { const int adv_ = ((T) + 2 < 68) ? KVBLK * LDK : 0; kp_ += adv_; vp_ += adv_; asm volatile("" : "+v"(kp_), "+v"(vp_)); } SBAR(); \
    if ((J) & 1) { pv16<((J) % 4) * (int)SHM_V, true>(o, vb0, pa, TA); } else { pv16<((J) % 4) * (int)SHM_V, true>(o, vb0, pa, TB); } \
    WBAR(4); } while (0)
  if (wu >= 4) __builtin_amdgcn_s_setprio(1);
  STEP16(0, 1); STEP16(1, 2); STEP16(2, 3); STEP16(3, 4); STEP16(4, 5); STEP16(5, 6); STEP16(6, 7);
  for (int t = 8; t < 68; t += 12) {
    STEP16(7, t); STEP16(8, t + 1); STEP16(9, t + 2); STEP16(10, t + 3); STEP16(11, t + 4);
    STEP16(0, t + 5); STEP16(1, t + 6); STEP16(2, t + 7); STEP16(3, t + 8); STEP16(4, t + 9); STEP16(5, t + 10); STEP16(6, t + 11);
  }
#undef STEP16
  __builtin_amdgcn_s_setprio(0);
  fsm16<0>(TB, l2, pa); fsm16<1>(TB, l2, pa); fsm16<2>(TB, l2, pa); fsm16<3>(TB, l2, pa); SBAR();
  pv16<3 * (int)SHM_V, false>(o, vb0, pa, TB);
  float rli[2][4];
  { float l0 = l2[0][0] + l2[0][1], l1 = l2[1][0] + l2[1][1];
    l0 += __shfl_xor(l0, 16); l0 += __shfl_xor(l0, 32); l1 += __shfl_xor(l1, 16); l1 += __shfl_xor(l1, 32);
    if (g == 0) { li_l[i16] = l0; li_l[16 + i16] = l1; } asm volatile("s_waitcnt lgkmcnt(0)" ::: "memory");
#pragma unroll
    for (int qb = 0; qb < 2; ++qb)
#pragma unroll
      for (int r = 0; r < 4; ++r) rli[qb][r] = __builtin_amdgcn_rcpf(li_l[qb * 16 + 4 * g + r]); }
  __syncthreads();
  { int ln_ = (int)__builtin_amdgcn_mbcnt_hi(~0u, __builtin_amdgcn_mbcnt_lo(~0u, 0u)); asm volatile("" : "+v"(ln_));
    char* wbase = lds + wid * 8192 + (ln_ >> 4) * 1024 + (ln_ & 15) * 2;
#pragma unroll
    for (int qb = 0; qb < 2; ++qb)
#pragma unroll
      for (int db = 0; db < 8; ++db)
#pragma unroll
        for (int r = 0; r < 4; ++r) *(unsigned short*)(wbase + (qb * 16 + r) * 256 + db * 32) = (unsigned short)(cvtpk(o[qb][db][r] * rli[qb][r], 0.f) & 0xffffu);
    asm volatile("s_waitcnt lgkmcnt(0)" ::: "memory");
    const char* rbase = lds + wid * 8192 + (ln_ >> 4) * 256 + (ln_ & 15) * 16;
    unsigned short* Ow = (unsigned short*)Ob + (long)(wid * QBLK + (ln_ >> 4)) * LDO + (ln_ & 15) * 8;
#pragma unroll
    for (int j = 0; j < 8; ++j) *(u32x4*)(Ow + (long)(4 * j) * LDO) = *(const u32x4*)(rbase + j * 1024); }
#undef WBAR
#undef SDMA
#undef GLDS4
}
#undef MF16
#undef KSWZ
#undef SBAR
}

constexpr int DM = 4096, NB = 4, SEQ = 4096, CTXL = 256, ML = NB * SEQ, MC = NB * CTXL, MT = ML + MC, FF = 16384;
constexpr int HQ = 32, HKV = 8, HD = 128, KVD = HKV * HD, NQKV = DM + 2 * KVD, SKV = SEQ + CTXL, NMOD = 6;
constexpr float LN_EPS = 1e-5f, RMS_EPS = 1e-6f, ALPHA = 1.4142135623730951f;
constexpr int NWAVES = 8;
static_assert(attn::HQ * attn::D == DM && attn::HKV * attn::D == KVD && SKV == 68 * 64, "attention strides; attn_body_b3 is unrolled for 68 key tiles");

constexpr size_t MiB = 1u << 20;
constexpr size_t WS_CTL = 0, CTL_ZERO_BYTES = 32768;
constexpr size_t WS_MOD = 1 * MiB;
constexpr size_t WS_ROPE = 2 * MiB;
constexpr size_t WS_WCI = 4 * MiB, WS_WCO = 100 * MiB, WS_W1A = 132 * MiB, WS_W2A = 260 * MiB, WS_WQKV = 388 * MiB, WS_WO = 436 * MiB, WS_W1B = 468 * MiB, WS_W2B = 596 * MiB;
constexpr size_t WS_A = 724 * MiB;
constexpr size_t WS_ZF = 860 * MiB;
constexpr size_t WS_Y = 1132 * MiB;
constexpr size_t WS_YS = 1268 * MiB;
constexpr size_t WS_SLAB = 1300 * MiB;
constexpr size_t WS_STATS = 3 * MiB;
constexpr size_t WS_BIG = 1404 * MiB;
constexpr size_t WS_GB = WS_BIG, WS_U = WS_BIG + 136 * MiB, WS_Z = WS_BIG + 272 * MiB;
constexpr size_t WS_Q = WS_BIG, WS_K = WS_BIG + 128 * MiB, WS_V = WS_K + 34 * MiB, WS_O = WS_V + 34 * MiB;
constexpr size_t WS_END = WS_BIG + 544 * MiB;
static_assert(WS_WCI + (size_t)3 * DM * DM * 2 <= WS_WCO && WS_W1A + (size_t)DM * FF * 2 <= WS_W2A && WS_WQKV + (size_t)NQKV * DM * 2 <= WS_WO && WS_W2B + (size_t)DM * FF * 2 <= WS_A, "weights map");
static_assert(WS_A + (size_t)MT * DM * 2 <= WS_ZF && WS_ZF + (size_t)MT * DM * 4 <= WS_Y && WS_Y + (size_t)MT * DM * 2 <= WS_YS && WS_YS + (size_t)3 * MC * DM * 2 <= WS_SLAB && WS_SLAB + (size_t)8 * MC * 2048 * 4 <= WS_BIG && WS_BIG + (size_t)MT * FF * 2 <= WS_END, "activation map");
static_assert(WS_Z + (size_t)MT * DM * 2 <= WS_END && WS_K + (size_t)NB * SKV * KVD * 2 <= WS_V && WS_O + (size_t)ML * DM * 2 <= WS_END && WS_Q + (size_t)ML * DM * 2 <= WS_K, "overlay map");
constexpr int CW_BAR = 4096;
static_assert((CW_BAR + 3456) * 4 <= (int)CTL_ZERO_BYTES, "barrier words inside the per-call memset");

constexpr int RING_OFF = 0, RING_BYTES = 131072;
constexpr int LDSCTL_OFF = RING_BYTES, MISC_OFF = LDSCTL_OFF + 320;
constexpr int LDS_BYTES = 147456;
static_assert(MISC_OFF + 128 <= LDS_BYTES && (int)attn::SHM_ATTN <= RING_BYTES, "LDS map");

#define GAS __attribute__((address_space(1)))
#define LAS __attribute__((address_space(3)))
typedef unsigned short bf16;
typedef unsigned v4u __attribute__((ext_vector_type(4)));
typedef unsigned v2u __attribute__((ext_vector_type(2)));
typedef float f32x4 __attribute__((ext_vector_type(4)));
typedef GAS unsigned gu32;
#define RLX_AGENT __ATOMIC_RELAXED, __HIP_MEMORY_SCOPE_AGENT
#define LDS_WAIT() asm volatile("s_waitcnt lgkmcnt(0)" ::: "memory")
#define VM_WAIT() asm volatile("s_waitcnt vmcnt(0)" ::: "memory")
__device__ __forceinline__ unsigned f2bf(float f) { unsigned u = __builtin_bit_cast(unsigned, f); return (u + 0x7fffu + ((u >> 16) & 1u)) >> 16; }
__device__ __forceinline__ unsigned pk2(float lo, float hi) { return f2bf(lo) | (f2bf(hi) << 16); }
typedef float f32x2_t __attribute__((ext_vector_type(2)));
typedef _Float16 f16x2_t __attribute__((ext_vector_type(2)));
__device__ __forceinline__ unsigned pkh2(float lo, float hi) { const f32x2_t v = {lo, hi}; return __builtin_bit_cast(unsigned, __builtin_convertvector(v, f16x2_t)); }
__device__ __forceinline__ float hlo(unsigned w) { return (float)__builtin_bit_cast(f16x2_t, w).x; }
__device__ __forceinline__ float hhi(unsigned w) { return (float)__builtin_bit_cast(f16x2_t, w).y; }
__device__ __forceinline__ float bflo(unsigned w) { return __builtin_bit_cast(float, w << 16); }
__device__ __forceinline__ float bfhi(unsigned w) { return __builtin_bit_cast(float, w & 0xffff0000u); }

#define XB_TMO      128
#define XB_XCNT(j)  (256  + 64 * (j))
#define XB_XSUB(j)  (1280 + 64 * (j))
#define XB_XGEN(j)  (2304 + 64 * (j))
#define XB_TOP      3328
#define XB_TOPGEN   3392
#define XCD_BAR_WORDS 3456
#define XB_SPIN_CAP (1u << 18)

__device__ __forceinline__ unsigned xb_ld(unsigned* p)              { return __hip_atomic_load(p, __ATOMIC_RELAXED, __HIP_MEMORY_SCOPE_AGENT); }
__device__ __forceinline__ unsigned xb_add(unsigned* p, unsigned v) { return __hip_atomic_fetch_add(p, v, __ATOMIC_RELAXED, __HIP_MEMORY_SCOPE_AGENT); }
__device__ __forceinline__ unsigned xb_xcc_id() { return (unsigned)__builtin_amdgcn_s_getreg((3 << 11) | 20) & 0xFu; }
#define XB_SPIN(cond, bar) do { unsigned _sp = 0; while (cond) { __builtin_amdgcn_s_sleep(1); \
    if ((++_sp & 255u) == 0u) { if (xb_ld(&(bar)[XB_TMO])) break; if (_sp > XB_SPIN_CAP) { atomicAdd(&(bar)[XB_TMO], 1u); break; } } } } while (0)

struct XcdBarrier {
    unsigned* bar; unsigned x;
    volatile LAS unsigned* st;
};

__device__ __forceinline__ XcdBarrier xcd_barrier_post(unsigned* bar, volatile LAS unsigned* st) {
    XcdBarrier b; b.bar = bar; b.x = xb_xcc_id(); b.st = st;
    if (threadIdx.x == 0) (void)xb_add(&bar[XB_XCNT(b.x)], 1u);
    return b;
}
__device__ __forceinline__ void xcd_barrier_complete(unsigned* bar, unsigned x, unsigned& nloc, unsigned& nx) {
    const unsigned G = gridDim.x * gridDim.y * gridDim.z;
    unsigned sum, cnt, mine, sp = 0u;
    for (;;) {
        sum = 0u; cnt = 0u; mine = 0u;
#pragma unroll
        for (unsigned j = 0; j < 16; ++j) { const unsigned c = xb_ld(&bar[XB_XCNT(j)]); sum += c; cnt += (c > 0u) ? 1u : 0u; mine = (j == x) ? c : mine; }
        if (sum == G) break;
        __builtin_amdgcn_s_sleep(1);
        if ((++sp & 255u) == 0u) { if (xb_ld(&bar[XB_TMO])) break; if (sp > XB_SPIN_CAP) { atomicAdd(&bar[XB_TMO], 1u); break; } }
    }
    nloc = mine > 0u ? mine : 1u; nx = cnt > 0u ? cnt : 1u;
}

__device__ __forceinline__ void xcd_barrier(const XcdBarrier& b) {
    asm volatile("s_waitcnt vmcnt(0)" ::: "memory");
    __syncthreads();
    if (threadIdx.x == 0) {
        unsigned* bar = b.bar;
        __builtin_amdgcn_s_waitcnt(0);
        unsigned nloc = b.st[0], nx = b.st[1];
        if (nloc == 0u) { xcd_barrier_complete(bar, b.x, nloc, nx); b.st[0] = nloc; b.st[1] = nx; }
        const unsigned old = xb_add(&bar[XB_XSUB(b.x)], 1u);
        const unsigned gen = old / nloc;
        if (old + 1u == (gen + 1u) * nloc) {
            __builtin_amdgcn_fence(__ATOMIC_RELEASE, "agent");
            asm volatile("s_waitcnt vmcnt(0)" ::: "memory");
            const unsigned og = xb_add(&bar[XB_TOP], 1u);
            const unsigned tg = og / nx;
            if (og + 1u == (tg + 1u) * nx) xb_add(&bar[XB_TOPGEN], 1u);
            else XB_SPIN(xb_ld(&bar[XB_TOPGEN]) == tg, bar);
            __builtin_amdgcn_fence(__ATOMIC_ACQUIRE, "agent");
            xb_add(&bar[XB_XGEN(b.x)], 1u);
            asm volatile("s_waitcnt vmcnt(0)" ::: "memory");
        } else {
            XB_SPIN(xb_ld(&bar[XB_XGEN(b.x)]) == gen, bar);
            __builtin_amdgcn_fence(__ATOMIC_ACQUIRE, "agent");
            asm volatile("s_waitcnt vmcnt(0)" ::: "memory");
        }
    }
    __syncthreads();
}


struct Frame {
    LAS unsigned char* lds;
    volatile LAS unsigned* MISC;
    int tid, wave, vcu, G;
    const float *x, *c, *ctx, *cctx, *ada_w, *ada_b, *ln_g, *ln_b, *mlp_w1, *mlp_w2, *conv_in_w, *conv_w, *conv_b, *conv_out_w, *qkv_w, *q_gain, *k_gain, *out_w;
    float* out;
    float *mod, *rope, *ZF, *slab, *stats;
    bf16 *Wci, *Wco, *W1a, *W2a, *Wqkv, *Wo, *W1b, *W2b, *A, *BIG, *GB, *U, *Z, *Q, *K, *V, *O, *Y, *YS;
};
template <int OFF> __device__ __forceinline__ unsigned long long karg64(int tok) {
    unsigned long long v; asm("s_load_dwordx2 %0, %1, %3 ; %2\n\ts_waitcnt lgkmcnt(0)" : "=s"(v) : "s"(__builtin_amdgcn_kernarg_segment_ptr()), "s"(tok), "n"(OFF)); return v; }
template <int K> __device__ __forceinline__ const float* karg_in(int tok) { return (const float*)(const GAS float*)karg64<8 * K>(tok); }
__device__ __forceinline__ void load_ptrs(Frame& F, int tok) {
    F.x = karg_in<0>(tok); F.c = karg_in<1>(tok); F.ctx = karg_in<2>(tok); F.cctx = karg_in<3>(tok); F.ada_w = karg_in<4>(tok); F.ada_b = karg_in<5>(tok); F.ln_g = karg_in<6>(tok); F.ln_b = karg_in<7>(tok);
    F.mlp_w1 = karg_in<8>(tok); F.mlp_w2 = karg_in<9>(tok); F.conv_in_w = karg_in<10>(tok); F.conv_w = karg_in<11>(tok); F.conv_b = karg_in<12>(tok); F.conv_out_w = karg_in<13>(tok);
    F.qkv_w = karg_in<14>(tok); F.q_gain = karg_in<15>(tok); F.k_gain = karg_in<16>(tok); F.out_w = karg_in<17>(tok); F.out = (float*)(GAS float*)karg64<144>(tok);
    unsigned char* ws = (unsigned char*)(GAS unsigned char*)karg64<152>(tok);
    F.mod = (float*)(ws + WS_MOD); F.rope = (float*)(ws + WS_ROPE); F.ZF = (float*)(ws + WS_ZF); F.slab = (float*)(ws + WS_SLAB); F.stats = (float*)(ws + WS_STATS);
    F.Wci = (bf16*)(ws + WS_WCI); F.Wco = (bf16*)(ws + WS_WCO); F.W1a = (bf16*)(ws + WS_W1A); F.W2a = (bf16*)(ws + WS_W2A); F.Wqkv = (bf16*)(ws + WS_WQKV); F.Wo = (bf16*)(ws + WS_WO);
    F.W1b = (bf16*)(ws + WS_W1B); F.W2b = (bf16*)(ws + WS_W2B); F.A = (bf16*)(ws + WS_A); F.BIG = (bf16*)(ws + WS_BIG); F.GB = (bf16*)(ws + WS_GB); F.U = (bf16*)(ws + WS_U); F.Z = (bf16*)(ws + WS_Z);
    F.Q = (bf16*)(ws + WS_Q); F.K = (bf16*)(ws + WS_K); F.V = (bf16*)(ws + WS_V); F.O = (bf16*)(ws + WS_O); F.Y = (bf16*)(ws + WS_Y); F.YS = (bf16*)(ws + WS_YS);
}
#define PH_BEGIN Frame F = F0; { int tok_; asm volatile("s_mov_b32 %0, 0" : "=s"(tok_)); load_ptrs(F, tok_); }
__device__ __forceinline__ int lane_id() { return (int)__builtin_amdgcn_mbcnt_hi(~0u, __builtin_amdgcn_mbcnt_lo(~0u, 0u)); }
__device__ __forceinline__ int tid_id() { return (int)threadIdx.x; }
__device__ __forceinline__ float wave_sum(float v) {
#pragma unroll
    for (int o = 1; o < 64; o <<= 1) v += __shfl_xor(v, o);
    return v;
}

__device__ __forceinline__ void p0_adaln(Frame& F) {
    LAS float* sl = (LAS float*)(F.lds + RING_OFF);
    LAS float* red = (LAS float*)(F.lds + RING_OFF + 81920);
    for (int i = tid_id(); i < 5 * DM; i += NWAVES * 64) { const int s = i >> 12, k = i & 4095; const float v = s < 4 ? F.c[s * DM + k] : F.cctx[k]; sl[i] = v / (1.f + __expf(-v)); }
    __syncthreads();
    const int rr = lane_id() >> 4, c4 = lane_id() & 15;
    for (int it = F.vcu; it < 2 * 384; it += F.G) {
        const int l = it / 384, cc = it % 384;
        const float* wp = F.ada_w + (size_t)l * DM * (NMOD * DM) + (size_t)(4 * F.wave + rr) * (NMOD * DM) + cc * 64 + c4 * 4;
        float acc[5][4];
#pragma unroll
        for (int s = 0; s < 5; ++s)
#pragma unroll
            for (int j = 0; j < 4; ++j) acc[s][j] = 0.f;
        for (int i = 0; i < 128; i += 8) {
            f32x4 w[8];
#pragma unroll
            for (int u = 0; u < 8; ++u) w[u] = *(const f32x4*)(wp + (size_t)(32 * (i + u)) * (NMOD * DM));
#pragma unroll
            for (int u = 0; u < 8; ++u) { const int k = 4 * F.wave + rr + 32 * (i + u);
#pragma unroll
                for (int s = 0; s < 5; ++s) { const float a = sl[s * DM + k];
#pragma unroll
                    for (int j = 0; j < 4; ++j) acc[s][j] += a * w[u][j]; } }
        }
#pragma unroll
        for (int s = 0; s < 5; ++s)
#pragma unroll
            for (int j = 0; j < 4; ++j) { float v = acc[s][j]; v += __shfl_xor(v, 16); v += __shfl_xor(v, 32); acc[s][j] = v; }
        if (lane_id() < 16) {
#pragma unroll
            for (int s = 0; s < 5; ++s)
#pragma unroll
                for (int j = 0; j < 4; ++j) red[(F.wave * 5 + s) * 64 + c4 * 4 + j] = acc[s][j];
        }
        __syncthreads();
        const int t320 = tid_id(); if (t320 < 320) { const int s = t320 >> 6, col = t320 & 63; float v = 0.f;
#pragma unroll
            for (int w = 0; w < 8; ++w) v += red[(w * 5 + s) * 64 + col];
            F.mod[(size_t)(l * 5 + s) * (NMOD * DM) + cc * 64 + col] = v + F.ada_b[l * (NMOD * DM) + cc * 64 + col]; }
        __syncthreads();
    }
}
template <int MODE>
__device__ __forceinline__ void p0_transpose_item(const float* W, int K, int N, bf16* WT, LAS float* scr, int item, int lane) {
    const int nblk = N / 32, kb = item / nblk, nb = item % nblk, k0 = 64 * kb, n0 = 32 * nb;
    int d0 = n0;
    if (MODE == 1) { if (n0 >= 8192) { const int j = n0 - 8192; d0 = 4096 + (j >> 7) * 256 + 128 + (j & 127); } else if (n0 >= 4096) { const int j = n0 - 4096; d0 = 4096 + (j >> 7) * 256 + (j & 127); } }
#pragma unroll 8
    for (int i = 0; i < 32; ++i) { const int kk = 2 * i + (lane >> 5); scr[kk * 33 + (lane & 31)] = W[(size_t)(k0 + kk) * N + n0 + (lane & 31)]; }
    LDS_WAIT(); asm volatile("" ::: "memory");
    const int c = lane & 7;
#pragma unroll
    for (int j = 0; j < 4; ++j) { const int n = (lane >> 3) + 8 * j; const LAS float* s = scr + (8 * c) * 33 + n;
        v4u o; o.x = pk2(s[0 * 33], s[1 * 33]); o.y = pk2(s[2 * 33], s[3 * 33]); o.z = pk2(s[4 * 33], s[5 * 33]); o.w = pk2(s[6 * 33], s[7 * 33]);
        *(GAS v4u*)(WT + (size_t)(d0 + n) * K + k0 + 8 * c) = o; }
    LDS_WAIT(); asm volatile("" ::: "memory");
}
__device__ __forceinline__ void p0_weights(Frame& F) {
    LAS float* scr = (LAS float*)(F.lds + RING_OFF + F.wave * 16384);
    const int gw = F.vcu * NWAVES + F.wave, NGW = F.G * NWAVES;
    constexpr int I_CI = (DM / 64) * (3 * DM / 32), I_SQ = (DM / 64) * (DM / 32), I_W1 = (DM / 64) * (FF / 32), I_W2 = (FF / 64) * (DM / 32), I_QKV = (DM / 64) * (NQKV / 32);
    constexpr int NITEMS = I_CI + I_SQ + 2 * I_W1 + 2 * I_W2 + I_QKV + I_SQ;
    for (int it = gw; it < NITEMS; it += NGW) {
        int r = it;
        if (r < I_CI) { p0_transpose_item<1>(F.conv_in_w, DM, 3 * DM, F.Wci, scr, r, lane_id()); continue; } r -= I_CI;
        if (r < I_SQ) { p0_transpose_item<0>(F.conv_out_w, DM, DM, F.Wco, scr, r, lane_id()); continue; } r -= I_SQ;
        if (r < I_W1) { p0_transpose_item<0>(F.mlp_w1, DM, FF, F.W1a, scr, r, lane_id()); continue; } r -= I_W1;
        if (r < I_W2) { p0_transpose_item<0>(F.mlp_w2, FF, DM, F.W2a, scr, r, lane_id()); continue; } r -= I_W2;
        if (r < I_QKV) { p0_transpose_item<0>(F.qkv_w, DM, NQKV, F.Wqkv, scr, r, lane_id()); continue; } r -= I_QKV;
        if (r < I_SQ) { p0_transpose_item<0>(F.out_w, DM, DM, F.Wo, scr, r, lane_id()); continue; } r -= I_SQ;
        if (r < I_W1) { p0_transpose_item<0>(F.mlp_w1 + (size_t)DM * FF, DM, FF, F.W1b, scr, r, lane_id()); continue; } r -= I_W1;
        p0_transpose_item<0>(F.mlp_w2 + (size_t)DM * FF, FF, DM, F.W2b, scr, r, lane_id());
    }
    if (F.vcu == F.G - 1) {
        for (int i = tid_id(); i < 64 * 32; i += NWAVES * 64) { const int pos = i >> 5, f = i & 31;
            const float inv = exp2f(-(float)(2 * f) * (13.287712379549449f / 64.f));
            const float ang = (float)pos * inv;
            const float n = rintf(ang * 0.15915494309189535f);
            float r = fmaf(-n, 6.28125f, ang); r = fmaf(-n, 1.9353071795864769e-3f, r);
            F.rope[2 * i] = cosf(r); F.rope[2 * i + 1] = sinf(r); }
    }
}
__device__ __forceinline__ void p1_modulate(Frame& F) {
    LAS float* Vf = (LAS float*)(F.lds + RING_OFF);
    const int RB = (MT + F.G - 1) / F.G, r_begin = F.vcu * RB, r_end = (r_begin + RB < MT) ? r_begin + RB : MT;
    const int lane = lane_id();
    for (int ra = r_begin; ra < r_end;) {
        const int set = ra < ML ? (ra >> 12) : 4;
        int seg_end = ra < ML ? (((ra >> 12) + 1) << 12) : MT; if (seg_end > r_end) seg_end = r_end;
        __syncthreads();
        { const float* sh = F.mod + (size_t)(set * 6 + 0) * DM; const float* sc = sh + DM;
          for (int i = tid_id(); i < DM; i += NWAVES * 64) { Vf[i] = 1.0f + sc[i]; Vf[DM + i] = sh[i]; } }
        __syncthreads();
        const LAS f32x4* V = (const LAS f32x4*)Vf + lane;
        for (int r = ra + F.wave; r < seg_end; r += NWAVES) {
            const GAS f32x4* xr = (const GAS f32x4*)(r < ML ? F.x + (size_t)r * DM : F.ctx + (size_t)(r - ML) * DM) + lane;
            GAS v2u* o8 = (GAS v2u*)(F.A + (size_t)r * DM) + lane;
            f32x4 v[16];
#pragma unroll
            for (int j = 0; j < 16; ++j) v[j] = xr[64 * j];
#pragma unroll
            for (int j = 0; j < 16; ++j) { const f32x4 a = v[j] * V[64 * j] + V[1024 + 64 * j]; v2u w; w.x = pk2(a.x, a.y); w.y = pk2(a.z, a.w); o8[64 * j] = w; }
        }
        ra = seg_end;
    }
    __syncthreads();
}
#ifndef ZF16
#define ZF16 1
#endif
template <int MODE>
__device__ __forceinline__ void stage_rows(Frame& F, int nrows, const float* g_old, const float* b_old, const float* gate0, const float* g_new, const float* b_new, const float* shift0, int nslab) {
    LAS float* Vf = (LAS float*)(F.lds + RING_OFF);
    const int RB = (nrows + F.G - 1) / F.G, r_begin = F.vcu * RB, r_end = (r_begin + RB < nrows) ? r_begin + RB : nrows;
    const int lane = lane_id();
    for (int ra = r_begin; ra < r_end;) {
        const int set = ra < ML ? (ra >> 12) : 4;
        int seg_end = ra < ML ? (((ra >> 12) + 1) << 12) : nrows; if (seg_end > r_end) seg_end = r_end;
        __syncthreads();
        { const float* gate = gate0 + (size_t)set * 6 * DM; const float* sh = shift0 + (size_t)set * 6 * DM; const float* sc = sh + DM;
          for (int i = tid_id(); i < DM; i += NWAVES * 64) {
              if (MODE != 0) { Vf[i] = ALPHA * g_old[i]; Vf[DM + i] = ALPHA * b_old[i]; }
              Vf[2 * DM + i] = gate[i];
              if (MODE != 2) { const float s1 = 1.0f + sc[i]; Vf[3 * DM + i] = g_new[i] * s1; Vf[4 * DM + i] = b_new[i] * s1 + sh[i]; }
              else { Vf[3 * DM + i] = g_new[i]; Vf[4 * DM + i] = b_new[i]; } } }
        __syncthreads();
        const LAS f32x4* V = (const LAS f32x4*)Vf + lane;
#define SR_LOAD(rr, vv, yy, mm, rs) do { \
            const GAS v2u* yr_ = (const GAS v2u*)(F.Y + (size_t)(rr) * DM) + lane; \
            if (MODE == 0 || !ZF16) { const GAS f32x4* zr_ = (const GAS f32x4*)(MODE == 0 ? ((rr) < ML ? F.x + (size_t)(rr) * DM : F.ctx + (size_t)((rr) - ML) * DM) : F.ZF + (size_t)(rr) * DM) + lane; \
                _Pragma("unroll") for (int j = 0; j < 16; ++j) { vv[j] = zr_[64 * j]; yy[j] = yr_[64 * j]; } } \
            else { const GAS v2u* zr_ = (const GAS v2u*)((const bf16*)F.ZF + (size_t)(rr) * DM) + lane; \
                _Pragma("unroll") for (int j = 0; j < 16; ++j) { const v2u w_ = zr_[64 * j]; vv[j] = (f32x4){hlo(w_.x), hhi(w_.x), hlo(w_.y), hhi(w_.y)}; yy[j] = yr_[64 * j]; } } \
            if (MODE != 0) { mm = F.stats[2 * (rr)]; rs = F.stats[2 * (rr) + 1]; } } while (0)
#define SR_ROW(r, v, m0, r0, vn, m0n, r0n) do { \
            if ((r) >= ML && nslab > 0) { \
                _Pragma("unroll") for (int j = 0; j < 16; ++j) { f32x4 t = (f32x4){bflo(yv[j].x), bfhi(yv[j].x), bflo(yv[j].y), bfhi(yv[j].y)}; \
                    for (int p = 0; p < nslab; ++p) { const v2u w = ((const GAS v2u*)(F.YS + (size_t)p * MC * DM + (size_t)((r) - ML) * DM) + lane)[64 * j]; t = t + (f32x4){bflo(w.x), bfhi(w.x), bflo(w.y), bfhi(w.y)}; } \
                    yv[j].x = pk2(t.x, t.y); yv[j].y = pk2(t.z, t.w); } \
            } \
            float s = 0.f; \
            _Pragma("unroll") for (int j = 0; j < 16; ++j) { const f32x4 yf = (f32x4){bflo(yv[j].x), bfhi(yv[j].x), bflo(yv[j].y), bfhi(yv[j].y)}; \
                if (MODE != 0) v[j] = (v[j] - m0) * r0 * V[64 * j] + V[1024 + 64 * j] + V[2048 + 64 * j] * yf; \
                else v[j] = v[j] * ALPHA + V[2048 + 64 * j] * yf; \
                s += (v[j].x + v[j].y) + (v[j].z + v[j].w); \
                if ((j & 3) == 3) asm volatile("" ::: "memory"); } \
            SR_LOAD((r) + NWAVES < seg_end ? (r) + NWAVES : (r), vn, yv, m0n, r0n);     \
            if (MODE != 2) { if (!ZF16) { GAS f32x4* zo = (GAS f32x4*)(F.ZF + (size_t)(r) * DM) + lane; \
                _Pragma("unroll") for (int j = 0; j < 16; ++j) zo[64 * j] = v[j]; } \
              else { GAS v2u* zo = (GAS v2u*)((bf16*)F.ZF + (size_t)(r) * DM) + lane; \
                _Pragma("unroll") for (int j = 0; j < 16; ++j) { v2u w_; w_.x = pkh2(v[j].x, v[j].y); w_.y = pkh2(v[j].z, v[j].w); zo[64 * j] = w_; } } } \
            const float mean = wave_sum(s) * (1.f / DM); float s2 = 0.f; \
            _Pragma("unroll") for (int j = 0; j < 16; ++j) { v[j] = v[j] - mean; s2 += (v[j].x * v[j].x + v[j].y * v[j].y) + (v[j].z * v[j].z + v[j].w * v[j].w); } \
            const float rstd = 1.f / sqrtf(wave_sum(s2) * (1.f / DM) + LN_EPS); \
            if (MODE == 2) { GAS f32x4* ho = (GAS f32x4*)(F.out + (size_t)(r) * DM) + lane; \
                _Pragma("unroll") for (int j = 0; j < 16; ++j) { ho[64 * j] = v[j] * rstd * V[3072 + 64 * j] + V[4096 + 64 * j]; if ((j & 3) == 3) asm volatile("" ::: "memory"); } \
            } else { \
                if (lane == 0) { F.stats[2 * (r)] = mean; F.stats[2 * (r) + 1] = rstd; } \
                GAS v2u* o8 = (GAS v2u*)(F.A + (size_t)(r) * DM) + lane; \
                _Pragma("unroll") for (int j = 0; j < 16; ++j) { const f32x4 a = v[j] * rstd * V[3072 + 64 * j] + V[4096 + 64 * j]; v2u w; w.x = pk2(a.x, a.y); w.y = pk2(a.z, a.w); o8[64 * j] = w; if ((j & 3) == 3) asm volatile("" ::: "memory"); } \
            } } while (0)
        f32x4 vA[16], vB[16]; v2u yv[16]; float mA = 0.f, rA = 1.f, mB = 0.f, rB = 1.f;
        int r = ra + F.wave;
        if (r < seg_end) SR_LOAD(r, vA, yv, mA, rA);
        for (; r < seg_end; r += 2 * NWAVES) {
            SR_ROW(r, vA, mA, rA, vB, mB, rB);
            if (r + NWAVES < seg_end) SR_ROW(r + NWAVES, vB, mB, rB, vA, mA, rA);
        }
#undef SR_ROW
#undef SR_LOAD
        ra = seg_end;
    }
    __syncthreads();
}
template <int MODE>
__device__ __forceinline__ void stage_rows2(Frame& F, int nrows, const float* g_old, const float* b_old, const float* gate0, const float* g_new, const float* b_new, const float* shift0, int nslab) {
    LAS float* P = (LAS float*)(F.lds + RING_OFF);
    const int tid = tid_id(), lane = tid & 63, wv = F.wave, c0 = tid * 8;
    int par = 0;
    for (int part = 0; part < 2; ++part) {
    const int p_lo = part ? ML : 0, p_hi = part ? nrows : (nrows < ML ? nrows : ML);
    if (p_hi <= p_lo) continue;
    const int RB = (p_hi - p_lo + F.G - 1) / F.G, r_begin = p_lo + F.vcu * RB, r_end = (r_begin + RB < p_hi) ? r_begin + RB : p_hi;
    for (int ra = r_begin; ra < r_end;) {
        const int set = ra < ML ? (ra >> 12) : 4;
        int seg_end = ra < ML ? (((ra >> 12) + 1) << 12) : nrows; if (seg_end > r_end) seg_end = r_end;
        const bool slab_on = (ra >= ML) && (nslab > 0);
        float V0[8], V1[8], V2[8], V3[8], V4[8];
        { const float* gate = gate0 + (size_t)set * 6 * DM + c0; const float* sh = shift0 + (size_t)set * 6 * DM + c0; const float* sc = sh + DM;
#pragma unroll
          for (int j = 0; j < 8; ++j) {
              if (MODE != 0) { V0[j] = ALPHA * g_old[c0 + j]; V1[j] = ALPHA * b_old[c0 + j]; } else { V0[j] = 0.f; V1[j] = 0.f; }
              V2[j] = gate[j];
              if (MODE != 2) { const float s1 = 1.0f + sc[j]; V3[j] = g_new[c0 + j] * s1; V4[j] = b_new[c0 + j] * s1 + sh[j]; } else { V3[j] = g_new[c0 + j]; V4[j] = b_new[c0 + j]; } } }
        const int last = seg_end - 1;
#define R2_DECL(S) v4u zq##S = {0u, 0u, 0u, 0u}, yq##S = {0u, 0u, 0u, 0u}, s1q##S = {0u, 0u, 0u, 0u}, s2q##S = {0u, 0u, 0u, 0u}, s3q##S = {0u, 0u, 0u, 0u}; f32x4 xa##S = {0.f, 0.f, 0.f, 0.f}, xb##S = {0.f, 0.f, 0.f, 0.f}; float mq##S = 0.f, rq##S = 1.f;
#define R2_LOAD(S, rr) do { const int r_ = (rr) < last ? (rr) : last; \
            yq##S = *(const GAS v4u*)(F.Y + (size_t)r_ * DM + c0); \
            if (MODE == 0) { const float* xp_ = (r_ < ML ? F.x + (size_t)r_ * DM : F.ctx + (size_t)(r_ - ML) * DM) + c0; xa##S = *(const GAS f32x4*)xp_; xb##S = *(const GAS f32x4*)(xp_ + 4); } \
            else { zq##S = *(const GAS v4u*)((const bf16*)F.ZF + (size_t)r_ * DM + c0); mq##S = F.stats[2 * r_]; rq##S = F.stats[2 * r_ + 1]; } \
            if (slab_on) { const bf16* sp_ = F.YS + (size_t)(r_ - ML) * DM + c0; s1q##S = *(const GAS v4u*)sp_; s2q##S = *(const GAS v4u*)(sp_ + (size_t)MC * DM); s3q##S = *(const GAS v4u*)(sp_ + (size_t)2 * MC * DM); } } while (0)
#define R2_PROC(S, rr) do { if ((rr) <= last) { const int r_ = (rr); float z[8]; \
            _Pragma("unroll") for (int q = 0; q < 4; ++q) { float y0 = bflo(yq##S[q]), y1 = bfhi(yq##S[q]); \
                if (slab_on) { y0 += bflo(s1q##S[q]) + bflo(s2q##S[q]) + bflo(s3q##S[q]); y1 += bfhi(s1q##S[q]) + bfhi(s2q##S[q]) + bfhi(s3q##S[q]); } \
                if (MODE == 0) { const float x0 = q < 2 ? xa##S[2 * q] : xb##S[2 * q - 4], x1 = q < 2 ? xa##S[2 * q + 1] : xb##S[2 * q - 3]; z[2 * q] = x0 * ALPHA + V2[2 * q] * y0; z[2 * q + 1] = x1 * ALPHA + V2[2 * q + 1] * y1; } \
                else { z[2 * q] = (hlo(zq##S[q]) - mq##S) * rq##S * V0[2 * q] + V1[2 * q] + V2[2 * q] * y0; z[2 * q + 1] = (hhi(zq##S[q]) - mq##S) * rq##S * V0[2 * q + 1] + V1[2 * q + 1] + V2[2 * q + 1] * y1; } } \
            if (MODE != 2) { v4u w_; _Pragma("unroll") for (int q = 0; q < 4; ++q) w_[q] = pkh2(z[2 * q], z[2 * q + 1]); *(GAS v4u*)((bf16*)F.ZF + (size_t)r_ * DM + c0) = w_; } \
            float s_ = 0.f, q_ = 0.f; _Pragma("unroll") for (int j = 0; j < 8; ++j) { s_ += z[j]; q_ += z[j] * z[j]; } \
            s_ = wave_sum(s_); q_ = wave_sum(q_); \
            if (lane == 0) { P[(par * 8 + wv) * 2] = s_; P[(par * 8 + wv) * 2 + 1] = q_; } \
            asm volatile("s_waitcnt lgkmcnt(0)" ::: "memory"); __builtin_amdgcn_s_barrier(); asm volatile("" ::: "memory"); \
            float S_ = 0.f, Q_ = 0.f; _Pragma("unroll") for (int w = 0; w < 8; ++w) { S_ += P[(par * 8 + w) * 2]; Q_ += P[(par * 8 + w) * 2 + 1]; } \
            par ^= 1; \
            const float mean = S_ * (1.f / DM), rstd = 1.f / sqrtf(Q_ * (1.f / DM) - mean * mean + LN_EPS); \
            if (MODE == 2) { f32x4 o0, o1; _Pragma("unroll") for (int j = 0; j < 4; ++j) { o0[j] = (z[j] - mean) * rstd * V3[j] + V4[j]; o1[j] = (z[4 + j] - mean) * rstd * V3[4 + j] + V4[4 + j]; } \
                float* op_ = F.out + (size_t)r_ * DM + c0; *(GAS f32x4*)op_ = o0; *(GAS f32x4*)(op_ + 4) = o1; } \
            else { if (tid == 0) { F.stats[2 * r_] = mean; F.stats[2 * r_ + 1] = rstd; } \
                v4u w_; _Pragma("unroll") for (int q = 0; q < 4; ++q) w_[q] = pk2((z[2 * q] - mean) * rstd * V3[2 * q] + V4[2 * q], (z[2 * q + 1] - mean) * rstd * V3[2 * q + 1] + V4[2 * q + 1]); \
                *(GAS v4u*)(F.A + (size_t)r_ * DM + c0) = w_; } } } while (0)
        R2_DECL(0) R2_DECL(1) R2_DECL(2) R2_DECL(3)
        R2_LOAD(0, ra); R2_LOAD(1, ra + 1); R2_LOAD(2, ra + 2);
        for (int r = ra; r < seg_end; r += 4) {
            R2_LOAD(3, r + 3); R2_PROC(0, r);
            R2_LOAD(0, r + 4); R2_PROC(1, r + 1);
            R2_LOAD(1, r + 5); R2_PROC(2, r + 2);
            R2_LOAD(2, r + 6); R2_PROC(3, r + 3);
        }
#undef R2_DECL
#undef R2_LOAD
#undef R2_PROC
        ra = seg_end;
    }
    }
    __syncthreads();
}
__device__ __forceinline__ void p3_conv(Frame& F) {
    const int gw = F.vcu * NWAVES + F.wave, NGW = F.G * NWAVES;
    for (int it = gw; it < (MT / 16) * 8; it += NGW) {
        const int rb = it >> 3, cc = it & 7, r0 = rb * 16, col = cc * 512 + lane_id() * 8;
        const int t0 = r0 < ML ? (r0 & (SEQ - 1)) : ((r0 - ML) & (CTXL - 1)), slen = r0 < ML ? SEQ : CTXL;
        float w0[8], w1[8], w2[8], cb[8];
#pragma unroll
        for (int j = 0; j < 8; ++j) { w0[j] = F.conv_w[col + j]; w1[j] = F.conv_w[DM + col + j]; w2[j] = F.conv_w[2 * DM + col + j]; cb[j] = F.conv_b[col + j]; }
        const GAS v4u* up = (const GAS v4u*)(F.U + (size_t)r0 * DM + col); const GAS v4u* gp = (const GAS v4u*)(F.GB + (size_t)r0 * DM + col); GAS v4u* zp = (GAS v4u*)(F.Z + (size_t)r0 * DM + col);
        const v4u zero = (v4u){0u, 0u, 0u, 0u};
        v4u prev = t0 > 0 ? up[-(DM / 8)] : zero, cur = up[0];
#pragma unroll 4
        for (int i = 0; i < 16; ++i) {
            const v4u nxt = (i < 15 || t0 + 16 < slen) ? up[(size_t)(i + 1) * (DM / 8)] : zero;
            const v4u gb = gp[(size_t)i * (DM / 8)];
            v4u o;
#pragma unroll
            for (int q = 0; q < 4; ++q) {
                const float c0 = bflo(prev[q]) * w0[2 * q] + bflo(cur[q]) * w1[2 * q] + bflo(nxt[q]) * w2[2 * q] + cb[2 * q];
                const float c1 = bfhi(prev[q]) * w0[2 * q + 1] + bfhi(cur[q]) * w1[2 * q + 1] + bfhi(nxt[q]) * w2[2 * q + 1] + cb[2 * q + 1];
                o[q] = pk2(bflo(gb[q]) * c0, bfhi(gb[q]) * c1); }
            zp[(size_t)i * (DM / 8)] = o; prev = cur; cur = nxt;
        }
    }
}
__device__ __forceinline__ void rms_rope8f(float (&x)[8], const float* gain8, const float* cs, bool rope, int lane) {
    float ss = 0.f;
#pragma unroll
    for (int j = 0; j < 8; ++j) ss += x[j] * x[j];
    ss += __shfl_xor(ss, 1); ss += __shfl_xor(ss, 2); ss += __shfl_xor(ss, 4); ss += __shfl_xor(ss, 8);
    const float rs = 1.f / sqrtf(ss * (1.f / HD) + RMS_EPS);
#pragma unroll
    for (int j = 0; j < 8; ++j) x[j] = x[j] * rs * gain8[j];
    if (rope) {
        const bool hi = (lane >> 2) & 1;
#pragma unroll
        for (int j = 0; j < 8; ++j) { const float p = __shfl_xor(x[j], 4); x[j] = x[j] * cs[2 * j] + (hi ? p : -p) * cs[2 * j + 1]; }
    }
}
__device__ __forceinline__ void rms_rope8(v4u& w, const float* gain8, const float* cs, bool rope, int lane) {
    float x[8];
#pragma unroll
    for (int q = 0; q < 4; ++q) { x[2 * q] = bflo(w[q]); x[2 * q + 1] = bfhi(w[q]); }
    rms_rope8f(x, gain8, cs, rope, lane);
#pragma unroll
    for (int q = 0; q < 4; ++q) w[q] = pk2(x[2 * q], x[2 * q + 1]);
}
__device__ __forceinline__ void p10_qknorm(Frame& F) {
    const int gw = F.vcu * NWAVES + F.wave, NGW = F.G * NWAVES;
    const int l16 = lane_id() & 15, axis = l16 >> 3, f0 = (l16 & 3) * 8;
    float qg[8], kg[8];
#pragma unroll
    for (int j = 0; j < 8; ++j) { qg[j] = F.q_gain[l16 * 8 + j]; kg[j] = F.k_gain[l16 * 8 + j]; }
    for (int r = ML + gw; r < ML + NB * SKV; r += NGW) {
        if (r < ML) {
            const int t = r & (SEQ - 1), pos = axis ? (t & 63) : (t >> 6);
            float cs[16];
#pragma unroll
            for (int j = 0; j < 4; ++j) { const f32x4 c4 = *(const GAS f32x4*)(F.rope + (size_t)(pos * 32 + f0) * 2 + 4 * j); cs[4 * j] = c4.x; cs[4 * j + 1] = c4.y; cs[4 * j + 2] = c4.z; cs[4 * j + 3] = c4.w; }
            GAS v4u* qp = (GAS v4u*)(F.Q + (size_t)r * DM) + lane_id();
#pragma unroll
            for (int j = 0; j < 8; ++j) { v4u w = qp[64 * j]; rms_rope8(w, qg, cs, true, lane_id()); qp[64 * j] = w; }
        } else {
            const int kr = r - ML, bb = kr / SKV, tk = kr - bb * SKV;
            GAS v4u* kp = (GAS v4u*)(F.K + (size_t)kr * KVD) + lane_id();
            if (tk >= CTXL) {
                const int t = tk - CTXL, pos = axis ? (t & 63) : (t >> 6);
                float cs[16];
#pragma unroll
                for (int j = 0; j < 4; ++j) { const f32x4 c4 = *(const GAS f32x4*)(F.rope + (size_t)(pos * 32 + f0) * 2 + 4 * j); cs[4 * j] = c4.x; cs[4 * j + 1] = c4.y; cs[4 * j + 2] = c4.z; cs[4 * j + 3] = c4.w; }
#pragma unroll
                for (int j = 0; j < 2; ++j) { v4u w = kp[64 * j]; rms_rope8(w, kg, cs, true, lane_id()); kp[64 * j] = w; }
            } else {
                const float* sp = F.slab + (size_t)(bb * CTXL + tk) * 2048 + lane_id() * 8;
                GAS v4u* vp = (GAS v4u*)(F.V + (size_t)kr * KVD) + lane_id();
#pragma unroll
                for (int j = 0; j < 4; ++j) {
                    f32x4 a = (f32x4){0.f, 0.f, 0.f, 0.f}, c = a;
#pragma unroll
                    for (int p = 0; p < 8; ++p) { a = a + *(const GAS f32x4*)(sp + (size_t)p * 1024 * 2048 + 512 * j); c = c + *(const GAS f32x4*)(sp + (size_t)p * 1024 * 2048 + 512 * j + 4); }
                    float x[8] = {a.x, a.y, a.z, a.w, c.x, c.y, c.z, c.w};
                    if (j < 2) rms_rope8f(x, kg, x, false, lane_id());
                    v4u w;
#pragma unroll
                    for (int q = 0; q < 4; ++q) w[q] = pk2(x[2 * q], x[2 * q + 1]);
                    if (j < 2) kp[64 * j] = w; else vp[64 * (j - 2)] = w;
                }
            }
        }
    }
}

#ifndef MK_SPLIT
#define MK_SPLIT 0
#endif
#ifndef REPMASK
#define REPMASK 0
#endif
#define REP(k, ...) do { { __VA_ARGS__ } if constexpr (((REPMASK >> (k)) & 1) != 0) { GRID_BAR(); { __VA_ARGS__ } } } while (0)
constexpr int N_PHASES = 17;
struct Args { const float* in[18]; float* out; unsigned char* ws; int ph_lo, ph_hi; };
__global__ void __launch_bounds__(NWAVES * 64, 2) dit_fwd(Args args) {
    extern __shared__ __attribute__((aligned(16))) unsigned char lds[];
    Frame F0;
    F0.lds = (LAS unsigned char*)lds;
    F0.MISC = (volatile LAS unsigned*)(F0.lds + MISC_OFF);
    F0.tid = threadIdx.x; F0.wave = __builtin_amdgcn_readfirstlane(F0.tid >> 6);
    F0.G = gridDim.x; { const int bx = blockIdx.x; F0.vcu = (F0.G % 8 == 0) ? (bx % 8) * (F0.G / 8) + bx / 8 : bx; }
    F0.x = F0.c = F0.ctx = F0.cctx = F0.ada_w = F0.ada_b = F0.ln_g = F0.ln_b = F0.mlp_w1 = F0.mlp_w2 = F0.conv_in_w = F0.conv_w = F0.conv_b = F0.conv_out_w = F0.qkv_w = F0.q_gain = F0.k_gain = F0.out_w = nullptr; F0.out = nullptr;
    F0.mod = F0.rope = F0.ZF = F0.slab = F0.stats = nullptr; F0.Wci = F0.Wco = F0.W1a = F0.W2a = F0.Wqkv = F0.Wo = F0.W1b = F0.W2b = F0.A = F0.BIG = F0.GB = F0.U = F0.Z = F0.Q = F0.K = F0.V = F0.O = F0.Y = F0.YS = nullptr;
    gu32* const ctl = (gu32*)(args.ws + WS_CTL);
    for (int u = F0.tid; u < (LDS_BYTES - LDSCTL_OFF) / 4; u += NWAVES * 64) ((LAS unsigned*)(F0.lds + LDSCTL_OFF))[u] = 0u;
    __syncthreads();
    XcdBarrier bar; bar.bar = (unsigned*)(ctl + CW_BAR); bar.x = 0; bar.st = nullptr;
    if (!MK_SPLIT) bar = xcd_barrier_post((unsigned*)(ctl + CW_BAR), F0.MISC + 8);
#ifndef BARREP
#define BARREP 1
#endif
#define GRID_BAR() do { if (!MK_SPLIT) { for (int b_ = 0; b_ < BARREP; ++b_) xcd_barrier(bar); } } while (0)
    const int lo = args.ph_lo, hi = args.ph_hi;
#define IN(k) (lo <= (k) && (k) < hi)
#define BOTH(k) (IN(k) && IN((k) + 1))
#define mod0 (F.mod)
#define mod1 (F.mod + (size_t)5 * NMOD * DM)

    if (IN(0)) { REP(0, PH_BEGIN  p0_adaln(F); __syncthreads(); p0_weights(F); __syncthreads(); ); if (BOTH(0)) GRID_BAR(); }
    if (IN(1)) { REP(1, PH_BEGIN  p1_modulate(F); ); if (BOTH(1)) GRID_BAR(); }
    if (IN(2)) { REP(2, PH_BEGIN  pg8::Gemm g{F.A, F.Wci, MT, 3 * DM, DM}; pg8::StaticOrder S; S.init(MT, 3 * DM, DM, F.G, F.vcu); pg8::EpiConvIn E{F.GB, F.U};
        pg8::gemm_phase<pg8::EpiConvIn, pg8::StaticOrder, true, true>(F.lds + RING_OFF, g, S, E); ); if (BOTH(2)) GRID_BAR(); }
    if (IN(3)) { REP(3, PH_BEGIN  p3_conv(F); ); if (BOTH(3)) GRID_BAR(); }
    if (IN(4)) { REP(4, PH_BEGIN  pg8::Gemm g{F.Z, F.Wco, MT, DM, DM}; pg8::SplitOrder S; S.init(DM, DM, 4, F.G, F.vcu); pg8::EpiY E{F.Y, F.YS};
        pg8::gemm_phase<pg8::EpiY, pg8::SplitOrder, true, true>(F.lds + RING_OFF, g, S, E); ); if (BOTH(4)) GRID_BAR(); }
    if (IN(5)) { REP(5, PH_BEGIN  stage_rows2<0>(F, MT, nullptr, nullptr, mod0 + 2 * DM, F.ln_g, F.ln_b, mod0 + 3 * DM, 3); ); if (BOTH(5)) GRID_BAR(); }
    if (IN(6)) { REP(6, PH_BEGIN  pg8::Gemm g{F.A, F.W1a, MT, FF, DM}; pg8::StaticOrder S; S.init(MT, FF, DM, F.G, F.vcu); pg8::EpiSqRelu E{F.BIG, FF};
        pg8::gemm_phase<pg8::EpiSqRelu, pg8::StaticOrder, true, true>(F.lds + RING_OFF, g, S, E); ); if (BOTH(6)) GRID_BAR(); }
    if (IN(7)) { REP(7, PH_BEGIN  pg8::Gemm g{F.BIG, F.W2a, MT, DM, FF}; pg8::SplitOrder S; S.init(DM, FF, 4, F.G, F.vcu); pg8::EpiY E{F.Y, F.YS};
        pg8::gemm_phase<pg8::EpiY, pg8::SplitOrder, true, true>(F.lds + RING_OFF, g, S, E); ); if (BOTH(7)) GRID_BAR(); }
    if (IN(8)) { REP(8, PH_BEGIN  stage_rows2<1>(F, MT, F.ln_g, F.ln_b, mod0 + 5 * DM, F.ln_g + DM, F.ln_b + DM, mod1 + 0 * DM, 3); ); if (BOTH(8)) GRID_BAR(); }
    if (IN(9)) { REP(9, PH_BEGIN  pg8::Gemm g{F.A, F.Wqkv, MT, NQKV, DM}; pg8::SplitOrder S; S.init(NQKV, DM, 8, F.G, F.vcu, 16, 8); pg8::EpiQKV E{F.Q, F.K, F.V, F.slab};
        pg8::gemm_phase<pg8::EpiQKV, pg8::SplitOrder, true, true>(F.lds + RING_OFF, g, S, E); ); if (BOTH(9)) GRID_BAR(); }
    if (IN(10)) { REP(10, PH_BEGIN  p10_qknorm(F); ); if (BOTH(10)) GRID_BAR(); }
    if (IN(11)) { REP(11, PH_BEGIN
        bool bound_ok; { const int l_ = lane_id(); float gq = fmaxf(fabsf(F.q_gain[l_]), fabsf(F.q_gain[64 + l_])), gk = fmaxf(fabsf(F.k_gain[l_]), fabsf(F.k_gain[64 + l_]));
            _Pragma("unroll") for (int o_ = 1; o_ < 64; o_ <<= 1) { gq = fmaxf(gq, __shfl_xor(gq, o_)); gk = fmaxf(gk, __shfl_xor(gk, o_)); }
            const float b2 = 11.313708499f * 1.4426950408889634f * gq * gk; bound_ok = __builtin_amdgcn_readfirstlane((b2 < 100.f) ? 1 : 0) != 0; }
        if (bound_ok) {
        for (int i = 0;; ++i) {
            int pair, idx;
            if (F.G == 256) { if (i >= 8) break; pair = (blockIdx.x & 7) * 4 + (i >> 1); idx = (i & 1) * 32 + (blockIdx.x >> 3); }
            else { const int uu = i * F.G + blockIdx.x; if (uu >= NB * HKV * 64) break; pair = uu >> 6; idx = uu & 63; }
            const int b = pair >> 3, kvh = pair & 7, h = kvh * 4 + (idx >> 4), qb = idx & 15;
            const size_t q0 = ((size_t)(b * SEQ + qb * 256) * HQ + h) * HD, k0 = ((size_t)b * SKV * HKV + kvh) * HD;
            attn::attn_body_c16((const attn::bf16*)F.Q + q0, (const attn::bf16*)F.K + k0, (const attn::bf16*)F.V + k0, (attn::bf16*)F.O + q0, (char*)lds + RING_OFF, F.lds + RING_OFF, F.q_gain, F.rope, qb * 256);
            __syncthreads();
        }
        } else {
        for (int i = 0;; ++i) {
            int pair, idx;
            if (F.G == 256) { if (i >= 8) break; pair = (blockIdx.x & 7) * 4 + (i >> 1); idx = (i & 1) * 32 + (blockIdx.x >> 3); }
            else { const int uu = i * F.G + blockIdx.x; if (uu >= NB * HKV * 64) break; pair = uu >> 6; idx = uu & 63; }
            const int b = pair >> 3, kvh = pair & 7, h = kvh * 4 + (idx >> 4), qb = idx & 15;
            const size_t q0 = ((size_t)(b * SEQ + qb * 256) * HQ + h) * HD, k0 = ((size_t)b * SKV * HKV + kvh) * HD;
            attn::attn_dense_body<attn::bf16, false>((const attn::bf16*)F.Q + q0, (const attn::bf16*)F.K + k0, (const attn::bf16*)F.V + k0, (attn::bf16*)F.O + q0, SKV, (char*)lds + RING_OFF, F.q_gain, F.rope, qb * 256);
            __syncthreads();
        }
        }
        ); if (BOTH(11)) GRID_BAR();
    }
    if (IN(12)) { REP(12, PH_BEGIN  pg8::Gemm g{F.O, F.Wo, ML, DM, DM}; pg8::StaticOrder S; S.init(ML, DM, DM, F.G, F.vcu); pg8::EpiY E{F.Y, F.YS};
        pg8::gemm_phase<pg8::EpiY, pg8::StaticOrder, true, true>(F.lds + RING_OFF, g, S, E); ); if (BOTH(12)) GRID_BAR(); }
    if (IN(13)) { REP(13, PH_BEGIN  stage_rows2<1>(F, ML, F.ln_g + DM, F.ln_b + DM, mod1 + 2 * DM, F.ln_g + 2 * DM, F.ln_b + 2 * DM, mod1 + 3 * DM, 0); ); if (BOTH(13)) GRID_BAR(); }
    if (IN(14)) { REP(14, PH_BEGIN  pg8::Gemm g{F.A, F.W1b, ML, FF, DM}; pg8::StaticOrder S; S.init(ML, FF, DM, F.G, F.vcu); pg8::EpiSqRelu E{F.BIG, FF};
        pg8::gemm_phase<pg8::EpiSqRelu, pg8::StaticOrder, true, true>(F.lds + RING_OFF, g, S, E); ); if (BOTH(14)) GRID_BAR(); }
    if (IN(15)) { REP(15, PH_BEGIN  pg8::Gemm g{F.BIG, F.W2b, ML, DM, FF}; pg8::StaticOrder S; S.init(ML, DM, FF, F.G, F.vcu); pg8::EpiY E{F.Y, F.YS};
        pg8::gemm_phase<pg8::EpiY, pg8::StaticOrder, true, true>(F.lds + RING_OFF, g, S, E); ); if (BOTH(15)) GRID_BAR(); }
    if (IN(16)) { REP(16, PH_BEGIN  stage_rows2<2>(F, ML, F.ln_g + 2 * DM, F.ln_b + 2 * DM, mod1 + 5 * DM, F.ln_g + 3 * DM, F.ln_b + 3 * DM, mod1, 0); ); }
#undef IN
#undef BOTH
}

extern "C" void kernel_launch(void* const* d_in, const int* in_sizes, int n_in, void* d_out, int out_size, void* d_ws, size_t ws_size, hipStream_t stream) {
    static int grid = 0;
    if (grid == 0) {
        if (n_in != 18 || in_sizes[0] != ML * DM || out_size != ML * DM || ws_size < WS_END) { fprintf(stderr, "kernel_launch: built for 18 inputs, x/out of %d floats, >= %zu bytes of workspace; got n_in %d, in0 %d, out %d, ws %zu; nothing launched\n", ML * DM, (size_t)WS_END, n_in, n_in > 0 ? in_sizes[0] : -1, out_size, ws_size); grid = -1; return; }
        int dev = 0, cus = 0, per_cu = 0;
        if (hipGetDevice(&dev) != hipSuccess || hipDeviceGetAttribute(&cus, hipDeviceAttributeMultiprocessorCount, dev) != hipSuccess) { fprintf(stderr, "kernel_launch: hipGetDevice / hipDeviceGetAttribute failed\n"); grid = -1; return; }
        if (hipFuncSetAttribute((const void*)dit_fwd, hipFuncAttributeMaxDynamicSharedMemorySize, LDS_BYTES) != hipSuccess) { fprintf(stderr, "kernel_launch: hipFuncSetAttribute failed\n"); grid = -1; return; }
        if (hipOccupancyMaxActiveBlocksPerMultiprocessor(&per_cu, (const void*)dit_fwd, NWAVES * 64, LDS_BYTES) != hipSuccess || per_cu < 1) { fprintf(stderr, "kernel_launch: occupancy query reports %d workgroups per CU; nothing launched\n", per_cu); (void)hipGetLastError(); grid = -1; return; }
        grid = cus;
    }
    if (grid < 0) return;
    if (hipMemsetAsync((char*)d_ws + WS_CTL, 0, CTL_ZERO_BYTES, stream) != hipSuccess) { fprintf(stderr, "kernel_launch: hipMemsetAsync failed\n"); return; }
    Args a{};
    for (int i = 0; i < 18; ++i) a.in[i] = (const float*)d_in[i];
    a.out = (float*)d_out; a.ws = (unsigned char*)d_ws;
#if MK_SPLIT
    for (int p = 0; p < N_PHASES; ++p) { a.ph_lo = p; a.ph_hi = p + 1; hipLaunchKernelGGL(dit_fwd, dim3(grid), dim3(NWAVES * 64), LDS_BYTES, stream, a); }
#else
    a.ph_lo = 0; a.ph_hi = N_PHASES;
    hipLaunchKernelGGL(dit_fwd, dim3(grid), dim3(NWAVES * 64), LDS_BYTES, stream, a);
#endif
    const hipError_t le = hipPeekAtLastError();
    if (le != hipSuccess) fprintf(stderr, "kernel_launch: launch failed: %s (grid %d x %d threads, %d B LDS)\n", hipGetErrorName(le), grid, NWAVES * 64, LDS_BYTES);
}
```

```cpp
#include <hip/hip_runtime.h>
#include <hip/hip_bf16.h>
#include <cstdio>
#include <cstdint>
namespace pg8 {
#define PG8_LAS __attribute__((address_space(3)))
typedef unsigned short bf16_t;
typedef short bf16x8 __attribute__((ext_vector_type(8)));
typedef float f32x4 __attribute__((ext_vector_type(4)));
typedef unsigned u32x4 __attribute__((ext_vector_type(4)));
typedef float f32x2 __attribute__((ext_vector_type(2)));
constexpr int BM = 256, BK = 64, HALF = 128, HTB = HALF * BK * 2  , STAGE_BYTES = 8 * HTB, NXCD = 8, WGM = 8;

__host__ __device__ __forceinline__ int lds_byte(int r, int c) { return r * 128 + ((((c >> 3) ^ (r >> 1)) & 7) << 4) + (c & 7) * 2; }
__host__ __device__ __forceinline__ void stage_rc(int b, int& R, int& C) { R = b >> 7; C = ((((b >> 4) ^ (R >> 1)) & 7) << 3); }
__host__ __device__ __forceinline__ int perm32(int rho) { const int n = rho >> 4, i = rho & 15; return 8 * (i >> 2) + 4 * n + (i & 3); }

struct Unit { int pm, pn, kt0, nkt, part; };
struct Gemm { const bf16_t* A; const bf16_t* Bt; int M, N, K; };

struct StaticOrder {
    int nM, nN, nwg, G, c, nkt;
    __host__ __device__ void init(int M, int N, int K, int G_, int c_) { nM = M / BM; nN = N / BM; nwg = nM * nN; G = G_; c = c_; nkt = K / BK; }
    __host__ __device__ void map(int L, int& pm, int& pn) const {
        const int wgid = L;
        const int nig = WGM * nN, gid = wgid / nig, fm = gid * WGM, gsz = (nM - fm) < WGM ? (nM - fm) : WGM;
        pm = fm + ((wgid % nig) % gsz); pn = (wgid % nig) / gsz;
    }
    __host__ __device__ bool next(int i, Unit& u) const {
        const long L = (long)i * G + c; if (L >= nwg) return false;
        int pm, pn; map((int)L, pm, pn); Unit r; r.pm = pm; r.pn = pn; r.kt0 = 0; r.nkt = nkt; r.part = 0; u = r; return true;
    }
    __device__ __forceinline__ void a_ready(const Unit&) const {}
    __device__ __forceinline__ void done(const Unit&) const {}
};

__device__ __forceinline__ unsigned cvt_pk_bf16(float lo, float hi) { unsigned r; asm volatile("v_cvt_pk_bf16_f32 %0, %1, %2" : "=v"(r) : "v"(lo), "v"(hi)); return r; }
__device__ __forceinline__ u32x4 pack8(const f32x4 v0, const f32x4 v1) { u32x4 w; w.x = cvt_pk_bf16(v0[0], v0[1]); w.y = cvt_pk_bf16(v0[2], v0[3]); w.z = cvt_pk_bf16(v1[0], v1[1]); w.w = cvt_pk_bf16(v1[2], v1[3]); return w; }

struct EpiConvIn {
    static constexpr bool PERM = true, AFTER_DRAIN = false;
    bf16_t* GB; bf16_t* U;
    __device__ __forceinline__ void operator()(const f32x4 (&acc)[2][2][4][2], const Unit& u, int wr, int wc, int fr, int fq) const {
        const int row0 = u.pm * BM + wr * 64 + fr;
        if (u.pn < 16) {
            const int col0 = u.pn * BM + wc * 32 + 8 * fq;
#pragma unroll
            for (int ai = 0; ai < 2; ++ai)
#pragma unroll
                for (int m = 0; m < 4; ++m) { bf16_t* rowp = GB + (size_t)(row0 + ai * HALF + m * 16) * 4096 + col0;
#pragma unroll
                    for (int bj = 0; bj < 2; ++bj) *(u32x4*)(rowp + bj * HALF) = pack8(acc[ai][bj][m][0], acc[ai][bj][m][1]); }
        } else {
            const int col0 = (u.pn - 16) * HALF + wc * 32 + 8 * fq;
#pragma unroll
            for (int ai = 0; ai < 2; ++ai)
#pragma unroll
                for (int m = 0; m < 4; ++m) { bf16_t* rowp = U + (size_t)(row0 + ai * HALF + m * 16) * 4096 + col0;
                    *(u32x4*)rowp = pack8(acc[ai][0][m][0] * acc[ai][1][m][0], acc[ai][0][m][1] * acc[ai][1][m][1]); }
        }
    }
};
struct EpiSqRelu {
    static constexpr bool PERM = true, AFTER_DRAIN = false;
    bf16_t* O; int ldc;
    __device__ __forceinline__ void operator()(const f32x4 (&acc)[2][2][4][2], const Unit& u, int wr, int wc, int fr, int fq) const {
        const int row0 = u.pm * BM + wr * 64 + fr, col0 = u.pn * BM + wc * 32 + 8 * fq;
#pragma unroll
        for (int ai = 0; ai < 2; ++ai)
#pragma unroll
            for (int m = 0; m < 4; ++m) { bf16_t* rowp = O + (size_t)(row0 + ai * HALF + m * 16) * ldc + col0;
#pragma unroll
                for (int bj = 0; bj < 2; ++bj) { f32x4 v0 = __builtin_elementwise_max(acc[ai][bj][m][0], (f32x4){0.f, 0.f, 0.f, 0.f}), v1 = __builtin_elementwise_max(acc[ai][bj][m][1], (f32x4){0.f, 0.f, 0.f, 0.f});
                    *(u32x4*)(rowp + bj * HALF) = pack8(v0 * v0, v1 * v1); } }
    }
};
struct EpiQKV {
    static constexpr bool PERM = true, AFTER_DRAIN = false;
    bf16_t* Q; bf16_t* Kc; bf16_t* Vc; float* slab;
    __device__ __forceinline__ void operator()(const f32x4 (&acc)[2][2][4][2], const Unit& u, int wr, int wc, int fr, int fq) const {
        const int lr0 = wr * 64 + fr, lc0 = wc * 32 + 8 * fq;
        if (u.pm >= 64) {
            float* sb = slab + ((size_t)u.part * 1024 + (size_t)(u.pm - 64) * BM) * 2048 + (u.pn - 16) * BM + lc0;
#pragma unroll
            for (int ai = 0; ai < 2; ++ai)
#pragma unroll
                for (int m = 0; m < 4; ++m) { float* rowp = sb + (size_t)(lr0 + ai * HALF + m * 16) * 2048;
#pragma unroll
                    for (int bj = 0; bj < 2; ++bj) { *(f32x4*)(rowp + bj * HALF) = acc[ai][bj][m][0]; *(f32x4*)(rowp + bj * HALF + 4) = acc[ai][bj][m][1]; } }
            return;
        }
        bf16_t* base; int ld;
        if (u.pn < 16) { base = Q + (size_t)u.pm * BM * 4096 + u.pn * BM; ld = 4096; }
        else { const int kvrow0 = (u.pm >> 4) * 4352 + 256 + (u.pm & 15) * 256;
               base = (u.pn < 20 ? Kc + (u.pn - 16) * BM : Vc + (u.pn - 20) * BM) + (size_t)kvrow0 * 1024; ld = 1024; }
#pragma unroll
        for (int ai = 0; ai < 2; ++ai)
#pragma unroll
            for (int m = 0; m < 4; ++m) { bf16_t* rowp = base + (size_t)(lr0 + ai * HALF + m * 16) * ld + lc0;
#pragma unroll
                for (int bj = 0; bj < 2; ++bj) *(u32x4*)(rowp + bj * HALF) = pack8(acc[ai][bj][m][0], acc[ai][bj][m][1]); }
    }
};
struct EpiY {
    static constexpr bool PERM = true, AFTER_DRAIN = false;
    bf16_t* Y; bf16_t* YS;
    __device__ __forceinline__ void operator()(const f32x4 (&acc)[2][2][4][2], const Unit& u, int wr, int wc, int fr, int fq) const {
        bf16_t* base = u.part == 0 ? Y + (size_t)u.pm * BM * 4096 : YS + (size_t)(u.part - 1) * 1024 * 4096 + (size_t)(u.pm - 64) * BM * 4096;
        base += (size_t)(wr * 64 + fr) * 4096 + u.pn * BM + wc * 32 + 8 * fq;
#pragma unroll
        for (int ai = 0; ai < 2; ++ai)
#pragma unroll
            for (int m = 0; m < 4; ++m) { bf16_t* rowp = base + (size_t)(ai * HALF + m * 16) * 4096;
#pragma unroll
                for (int bj = 0; bj < 2; ++bj) *(u32x4*)(rowp + bj * HALF) = pack8(acc[ai][bj][m][0], acc[ai][bj][m][1]); }
    }
};
struct SplitOrder {
    StaticOrder so; int nlat, nsplit, nsub, nn, pn0;
    __host__ __device__ void init(int N, int K, int nsplit_, int G_, int c_, int pn0_ = 0, int nnc = -1) { so.init(16384, N, K, G_, c_); nlat = so.nwg; nsplit = nsplit_; pn0 = pn0_; nn = nnc < 0 ? N / BM : nnc; nsub = 4 * nn * nsplit; }
    __host__ __device__ bool next(int i, Unit& u) const {
        const long L = (long)i * so.G + so.c; const bool lat = L < nlat;
        int pm = 0, pn = 0; so.map((int)(lat ? L : 0), pm, pn);
        const int j = (int)(L - nlat), cu = j / nsplit, part = j % nsplit, nk = so.nkt / nsplit;
        Unit r; r.pm = lat ? pm : 64 + cu / nn; r.pn = lat ? pn : pn0 + cu % nn; r.nkt = lat ? so.nkt : nk; r.kt0 = lat ? 0 : part * nk; r.part = lat ? 0 : part;
        u = r; return lat || j < nsub;
    }
    __device__ __forceinline__ void a_ready(const Unit&) const {}
    __device__ __forceinline__ void done(const Unit&) const {}
};
template <class Epi, class Sched, bool ALIGN_EPI = false, bool SP2 = false>
__device__ __forceinline__ void gemm_phase(PG8_LAS unsigned char* lds, const Gemm g, const Sched& S, const Epi& E) {
    const int tid = threadIdx.x, wid = __builtin_amdgcn_readfirstlane(tid >> 6), lane = tid & 63, wr = wid >> 2, wc = wid & 3, fr = lane & 15, fq = lane >> 4;
    const int K = g.K;
    unsigned voffA[2], voffB[2];
#pragma unroll
    for (int i = 0; i < 2; ++i) { int R, C; stage_rc(tid * 16 + i * 8192, R, C); const int Rb = Epi::PERM ? ((R & ~31) + perm32(R & 31)) : R;
        voffA[i] = (unsigned)(R * K + C) * 2u; voffB[i] = (unsigned)(Rb * K + C) * 2u; }
    const size_t kstep = (size_t)(BK * 2);
    const size_t hstep = (size_t)HALF * K * 2;
    const size_t tstep = 2 * hstep;
    const unsigned ldsw = (unsigned)wid * 1024u;
    const int aoff0 = lds_byte(wr * 64 + fr, fq * 8), aoff1 = lds_byte(wr * 64 + fr, fq * 8 + 32), boff0 = lds_byte(wc * 32 + fr, fq * 8), boff1 = lds_byte(wc * 32 + fr, fq * 8 + 32);
#define PG8_SA(b, h) (((b) * 2 + (h)) * HTB)
#define PG8_SB(b, h) ((4 + (b) * 2 + (h)) * HTB)
#define PG8_STAGE(bufoff, gbase, voff) do { _Pragma("unroll") for (int _i = 0; _i < 2; ++_i) \
        __builtin_amdgcn_global_load_lds((const unsigned*)((const char*)(gbase) + (voff)[_i]), (PG8_LAS unsigned*)(lds + (bufoff) + ldsw + _i * 8192), 16, 0, 0); } while (0)
#define PG8_LDA(dst, b, h) do { _Pragma("unroll") for (int m = 0; m < 4; ++m) _Pragma("unroll") for (int k = 0; k < 2; ++k) dst[m][k] = *(const PG8_LAS bf16x8*)(lds + PG8_SA(b, h) + (k ? aoff1 : aoff0) + m * 2048); } while (0)
#define PG8_LDB(dst, b, h) do { _Pragma("unroll") for (int n = 0; n < 2; ++n) _Pragma("unroll") for (int k = 0; k < 2; ++k) dst[n][k] = *(const PG8_LAS bf16x8*)(lds + PG8_SB(b, h) + (k ? boff1 : boff0) + n * 2048); } while (0)
#define PG8_MMA(ai, bj, At, Bt) do { __builtin_amdgcn_s_setprio(1); _Pragma("unroll") for (int m = 0; m < 4; ++m) _Pragma("unroll") for (int n = 0; n < 2; ++n) _Pragma("unroll") for (int k = 0; k < 2; ++k) \
        acc[ai][bj][m][n] = __builtin_amdgcn_mfma_f32_16x16x32_bf16(Bt[n][k], At[m][k], acc[ai][bj][m][n], 0, 0, 0); __builtin_amdgcn_s_setprio(0); } while (0)
#define PG8_MMA_NP(ai, bj, At, Bt) do { _Pragma("unroll") for (int m = 0; m < 4; ++m) _Pragma("unroll") for (int j = 0; j < 4; ++j) { const int jj = (m & 1) ? 3 - j : j, n = jj >> 1, k = (jj & 1) ^ (jj >> 1); \
        acc[ai][bj][m][n] = __builtin_amdgcn_mfma_f32_16x16x32_bf16(Bt[n][k], At[m][k], acc[ai][bj][m][n], 0, 0, 0); if (j & 1) __builtin_amdgcn_sched_barrier(0); } } while (0)
#define PG8_MMA2(ai, At, B0_, B1_) do { __builtin_amdgcn_s_setprio(1); PG8_MMA_NP(ai, 0, At, B0_); PG8_MMA_NP(ai, 1, At, B1_); __builtin_amdgcn_s_setprio(0); } while (0)
#define PG8_WAIT_V(n) asm volatile("s_waitcnt vmcnt(" #n ")" ::: "memory")
#define PG8_WAIT_L(n) asm volatile("s_waitcnt lgkmcnt(" #n ")" ::: "memory")
#define PG8_BAR __builtin_amdgcn_s_barrier()
#define PG8_SCHED __builtin_amdgcn_sched_barrier(0)
    Unit cur, nxt; int ui = 0;
    if (!S.next(0, cur)) return;
    f32x4 acc[2][2][4][2];
#pragma unroll
    for (int a = 0; a < 2; ++a)
#pragma unroll
        for (int b = 0; b < 2; ++b)
#pragma unroll
            for (int m = 0; m < 4; ++m)
#pragma unroll
                for (int n = 0; n < 2; ++n) acc[a][b][m][n] = (f32x4){0.f, 0.f, 0.f, 0.f};
    bf16x8 At[4][2], B0[2][2], B1[2][2];
    const char* cA = (const char*)g.A + (size_t)cur.pm * tstep + (size_t)cur.kt0 * kstep; const char* cB = (const char*)g.Bt + (size_t)cur.pn * tstep + (size_t)cur.kt0 * kstep;
    S.a_ready(cur);
    if constexpr (SP2) {
        PG8_STAGE(PG8_SB(0, 0), cB, voffB); PG8_STAGE(PG8_SB(0, 1), cB + hstep, voffB); PG8_STAGE(PG8_SA(0, 0), cA, voffA); PG8_STAGE(PG8_SA(0, 1), cA + hstep, voffA);
        if (wr == 1) PG8_BAR;
        PG8_WAIT_V(2); PG8_BAR;
        PG8_STAGE(PG8_SB(1, 0), cB + kstep, voffB); PG8_STAGE(PG8_SA(1, 0), cA + kstep, voffA); PG8_STAGE(PG8_SB(1, 1), cB + hstep + kstep, voffB);
        PG8_WAIT_V(6); PG8_BAR;
    } else {
        PG8_STAGE(PG8_SB(0, 0), cB, voffB); PG8_STAGE(PG8_SA(0, 0), cA, voffA); PG8_STAGE(PG8_SB(0, 1), cB + hstep, voffB); PG8_STAGE(PG8_SA(0, 1), cA + hstep, voffA);
        if (wr == 1) PG8_BAR;
        PG8_WAIT_V(4); PG8_BAR;
        PG8_STAGE(PG8_SB(1, 0), cB + kstep, voffB); PG8_STAGE(PG8_SA(1, 0), cA + kstep, voffA); PG8_STAGE(PG8_SB(1, 1), cB + hstep + kstep, voffB);
        PG8_WAIT_V(6); PG8_BAR;
    }
    for (;;) {
        const bool has_next = S.next(ui + 1, nxt);
        const char* nA = has_next ? (const char*)g.A + (size_t)nxt.pm * tstep + (size_t)nxt.kt0 * kstep : cA; const char* nB = has_next ? (const char*)g.Bt + (size_t)nxt.pn * tstep + (size_t)nxt.kt0 * kstep : cB;
        const int nt = cur.nkt;
        for (int t = 0; t < nt; t += 2) {
            const bool last = (t == nt - 2);
            const char* a1 = cA + (size_t)(t + 1) * kstep;
            const char* a2 = last ? nA : cA + (size_t)(t + 2) * kstep; const char* b2 = last ? nB : cB + (size_t)(t + 2) * kstep;
            const char* a3 = a2 + kstep; const char* b3 = b2 + kstep;
            if (last && has_next) S.a_ready(nxt);
            if constexpr (SP2) {
            PG8_LDB(B0, 0, 0); PG8_LDB(B1, 0, 1); PG8_SCHED; PG8_LDA(At, 0, 0); PG8_STAGE(PG8_SA(1, 1), a1 + hstep, voffA);
            PG8_WAIT_V(8); PG8_WAIT_L(0); PG8_BAR; PG8_MMA2(0, At, B0, B1); PG8_BAR; PG8_SCHED;
            PG8_LDA(At, 0, 1); PG8_STAGE(PG8_SB(0, 0), b2, voffB); PG8_STAGE(PG8_SB(0, 1), b2 + hstep, voffB); PG8_STAGE(PG8_SA(0, 0), a2, voffA);
            PG8_WAIT_V(8); PG8_WAIT_L(0); PG8_BAR; PG8_MMA2(1, At, B0, B1); PG8_BAR; PG8_SCHED;
            PG8_LDB(B0, 1, 0); PG8_LDB(B1, 1, 1); PG8_SCHED; PG8_LDA(At, 1, 0); PG8_STAGE(PG8_SA(0, 1), a2 + hstep, voffA);
            PG8_WAIT_V(8); PG8_WAIT_L(0); PG8_BAR; PG8_MMA2(0, At, B0, B1); PG8_BAR; PG8_SCHED;
            PG8_LDA(At, 1, 1); PG8_STAGE(PG8_SB(1, 0), b3, voffB); PG8_STAGE(PG8_SB(1, 1), b3 + hstep, voffB); PG8_STAGE(PG8_SA(1, 0), a3, voffA);
            PG8_WAIT_V(8); PG8_WAIT_L(0); PG8_BAR; PG8_MMA2(1, At, B0, B1); PG8_BAR; PG8_SCHED;
            } else {
            PG8_LDB(B0, 0, 0); PG8_SCHED; PG8_LDA(At, 0, 0); PG8_STAGE(PG8_SA(1, 1), a1 + hstep, voffA);
            PG8_WAIT_L(8); PG8_BAR; PG8_WAIT_L(0); PG8_MMA(0, 0, At, B0); PG8_BAR; PG8_SCHED;
            PG8_LDB(B1, 0, 1); PG8_STAGE(PG8_SB(0, 0), b2, voffB);
            PG8_BAR; PG8_WAIT_L(0); PG8_MMA(0, 1, At, B1); PG8_BAR;
            PG8_LDA(At, 0, 1); PG8_STAGE(PG8_SA(0, 0), a2, voffA);
            PG8_BAR; PG8_WAIT_L(0); PG8_MMA(1, 0, At, B0); PG8_BAR; PG8_SCHED;
            PG8_STAGE(PG8_SB(0, 1), b2 + hstep, voffB);
            PG8_WAIT_V(6); PG8_BAR; PG8_MMA(1, 1, At, B1); PG8_BAR;
            PG8_LDB(B0, 1, 0); PG8_SCHED; PG8_LDA(At, 1, 0); PG8_STAGE(PG8_SA(0, 1), a2 + hstep, voffA);
            PG8_WAIT_L(8); PG8_BAR; PG8_WAIT_L(0); PG8_MMA(0, 0, At, B0); PG8_BAR; PG8_SCHED;
            PG8_LDB(B1, 1, 1); PG8_STAGE(PG8_SB(1, 0), b3, voffB);
            PG8_BAR; PG8_WAIT_L(0); PG8_MMA(0, 1, At, B1); PG8_BAR;
            PG8_LDA(At, 1, 1); PG8_STAGE(PG8_SA(1, 0), a3, voffA);
            PG8_BAR; PG8_WAIT_L(0); PG8_MMA(1, 0, At, B0); PG8_BAR; PG8_SCHED;
            PG8_STAGE(PG8_SB(1, 1), b3 + hstep, voffB);
            PG8_WAIT_V(6); PG8_BAR; PG8_MMA(1, 1, At, B1); PG8_BAR;
            }
        }
        if constexpr (ALIGN_EPI) { if (wr == 0) PG8_BAR; }
        if constexpr (!Epi::AFTER_DRAIN) { E(acc, cur, wr, wc, fr, fq); S.done(cur); }
        if (!has_next) break;
#pragma unroll
        for (int a = 0; a < 2; ++a)
#pragma unroll
            for (int b = 0; b < 2; ++b)
#pragma unroll
                for (int m = 0; m < 4; ++m)
#pragma unroll
                    for (int n = 0; n < 2; ++n) acc[a][b][m][n] = (f32x4){0.f, 0.f, 0.f, 0.f};
        cur = nxt; cA = nA; cB = nB; ++ui;
        if constexpr (ALIGN_EPI) { if (wr == 1) PG8_BAR; }
    }
    PG8_WAIT_V(0);
    if constexpr (!ALIGN_EPI) { if (wr == 0) PG8_BAR; }
    PG8_BAR;
    if constexpr (Epi::AFTER_DRAIN) { E.fused(acc, cur, wr, wc, fr, fq, lds, wid, lane); S.done(cur); }
#undef PG8_SA
#undef PG8_SB
#undef PG8_STAGE
#undef PG8_LDA
#undef PG8_LDB
#undef PG8_MMA
#undef PG8_WAIT_V
#undef PG8_WAIT_L
#undef PG8_BAR
#undef PG8_SCHED
}
}

namespace attn {
using bf16 = __hip_bfloat16;
constexpr int   D = 128, NW = 8, QBLK = 32, KVBLK = 64, HQ = 32, HKV = 8;
constexpr float SCALE = 0.088388347648318440f;
constexpr float THR = 8.f;
constexpr int SDEPTH = 2;
constexpr int LDQ = HQ * D, LDK = HKV * D, LDO = LDQ;
constexpr size_t SHM_V = KVBLK * D * 2, SHM_K = KVBLK * D * 2, SHM_ATTN = 4 * SHM_V + 3 * SHM_K + NW * 64 * 4;
using bf16x8 = __attribute__((ext_vector_type(8))) short;
using s16x4  = __attribute__((ext_vector_type(4))) short;
using f32x16 = __attribute__((ext_vector_type(16))) float;
using f32x8  = __attribute__((ext_vector_type(8))) float;
using f32x2  = __attribute__((ext_vector_type(2))) float;
using u32x4  = __attribute__((ext_vector_type(4))) unsigned;
#define KSWZ(row, colB) ((row) * 256 + ((colB) ^ (((row) & 15) << 4)))
#define SBAR() __builtin_amdgcn_sched_barrier(0)
__device__ __forceinline__ int crow(int r, int hi) { return (r & 3) + 8 * (r >> 2) + 4 * hi; }
__device__ __forceinline__ unsigned cvtpk(float lo, float hi) {
  unsigned r; asm volatile("v_cvt_pk_bf16_f32 %0, %1, %2" : "=v"(r) : "v"(lo), "v"(hi)); return r;
}
template <typename TIn> struct Stage;
template <> struct Stage<bf16>  { using T = bf16x8;
  __device__ static __forceinline__ T ld8(const bf16* p) { return *reinterpret_cast<const bf16x8*>(p); }
  __device__ static __forceinline__ bf16x8 tobf(T x) { return x; } };
template <> struct Stage<float> { using T = f32x8;
  __device__ static __forceinline__ T ld8(const float* p) { return *reinterpret_cast<const f32x8*>(p); }
  __device__ static __forceinline__ bf16x8 tobf(T x) {
    u32x4 w = {cvtpk(x[0], x[1]), cvtpk(x[2], x[3]), cvtpk(x[4], x[5]), cvtpk(x[6], x[7])}; return *reinterpret_cast<bf16x8*>(&w); } };

__device__ __forceinline__ void partialSM(f32x16& p0, f32x16& p1, float& m_reg, float& mn, float& alpha) {
  constexpr float C = SCALE * 1.4426950408889634f;
  float pmax = p0[0]; for (int r = 1; r < 16; ++r) pmax = fmaxf(pmax, p0[r]); for (int r = 0; r < 16; ++r) pmax = fmaxf(pmax, p1[r]);
  { auto rr = __builtin_amdgcn_permlane32_swap(__float_as_uint(pmax), __float_as_uint(pmax), false, false);
    pmax = fmaxf(__uint_as_float(rr[0]), __uint_as_float(rr[1])); }
  if (__builtin_expect(__all(pmax - m_reg <= THR / SCALE), 1)) { mn = m_reg; alpha = 1.f; }
  else { mn = fmaxf(m_reg, pmax); alpha = __builtin_amdgcn_exp2f((m_reg - mn) * C); m_reg = mn; }
  float mnC = -mn * C;
  for (int r = 0; r < 16; ++r) p0[r] = fmaf(p0[r], C, mnC); for (int r = 0; r < 16; ++r) p1[r] = fmaf(p1[r], C, mnC);
  for (int r = 0; r < 16; ++r) p0[r] = __builtin_amdgcn_exp2f(p0[r]);
}
__device__ __forceinline__ void finishSM(f32x16& p0, f32x16& p1, float alpha, float& l_reg, bf16x8& pa0, bf16x8& pa1, bf16x8& pa2, bf16x8& pa3) {
  for (int r = 0; r < 16; ++r) p1[r] = __builtin_amdgcn_exp2f(p1[r]);
  float ps = 0; for (int r = 0; r < 16; ++r) ps += p0[r]; for (int r = 0; r < 16; ++r) ps += p1[r];
  { auto rr = __builtin_amdgcn_permlane32_swap(__float_as_uint(ps), __float_as_uint(ps), false, false);
    ps = __uint_as_float(rr[0]) + __uint_as_float(rr[1]); }
  l_reg = l_reg * alpha + ps;
#define PK4(P, BASE, OUT) do { unsigned a0 = cvtpk(P[BASE + 0], P[BASE + 1]), a1 = cvtpk(P[BASE + 2], P[BASE + 3]);   \
    unsigned b0 = cvtpk(P[BASE + 4], P[BASE + 5]), b1 = cvtpk(P[BASE + 6], P[BASE + 7]);                              \
    auto r0 = __builtin_amdgcn_permlane32_swap(a0, b0, false, false); auto r1 = __builtin_amdgcn_permlane32_swap(a1, b1, false, false); \
    u32x4 w = {r0[0], r1[0], r0[1], r1[1]}; OUT = *reinterpret_cast<bf16x8*>(&w); } while (0)
  PK4(p0, 0, pa0); PK4(p0, 8, pa1); PK4(p1, 0, pa2); PK4(p1, 8, pa3);
#undef PK4
}
__device__ __forceinline__ void partialSM_b(f32x16& p0) {
  for (int r = 0; r < 16; ++r) p0[r] = __builtin_amdgcn_exp2f(p0[r]);
}
__device__ __forceinline__ void finishSM_b(f32x16& p0, f32x16& p1, float& l_reg, bf16x8& pa0, bf16x8& pa1, bf16x8& pa2, bf16x8& pa3) {
  for (int r = 0; r < 16; ++r) p1[r] = __builtin_amdgcn_exp2f(p1[r]);
  float ps = 0; for (int r = 0; r < 16; ++r) ps += p0[r]; for (int r = 0; r < 16; ++r) ps += p1[r];
  { auto rr = __builtin_amdgcn_permlane32_swap(__float_as_uint(ps), __float_as_uint(ps), false, false);
    ps = __uint_as_float(rr[0]) + __uint_as_float(rr[1]); }
  l_reg += ps;
#define PK4(P, BASE, OUT) do { unsigned a0 = cvtpk(P[BASE + 0], P[BASE + 1]), a1 = cvtpk(P[BASE + 2], P[BASE + 3]);   \
    unsigned b0 = cvtpk(P[BASE + 4], P[BASE + 5]), b1 = cvtpk(P[BASE + 6], P[BASE + 7]);                              \
    auto r0 = __builtin_amdgcn_permlane32_swap(a0, b0, false, false); auto r1 = __builtin_amdgcn_permlane32_swap(a1, b1, false, false); \
    u32x4 w = {r0[0], r1[0], r0[1], r1[1]}; OUT = *reinterpret_cast<bf16x8*>(&w); } while (0)
  PK4(p0, 0, pa0); PK4(p0, 8, pa1); PK4(p1, 0, pa2); PK4(p1, 8, pa3);
#undef PK4
}
__device__ __forceinline__ void qkt(f32x16& p0, f32x16& p1, const bf16* Ks, const bf16x8* qr, int r32, int hi) {
  p0 = f32x16{}; p1 = f32x16{};
  for (int d0 = 0; d0 < 8; ++d0) { int cb = (d0 * 16 + hi * 8) * 2;
    bf16x8 b0 = *reinterpret_cast<const bf16x8*>((const char*)Ks + KSWZ(r32, cb));
    bf16x8 b1 = *reinterpret_cast<const bf16x8*>((const char*)Ks + KSWZ(32 + r32, cb));
    p0 = __builtin_amdgcn_mfma_f32_32x32x16_bf16(b0, qr[d0], p0, 0, 0, 0);
    p1 = __builtin_amdgcn_mfma_f32_32x32x16_bf16(b1, qr[d0], p1, 0, 0, 0); }
}
template <int OFF> __device__ __forceinline__ bf16x8 k_read(int ka) { bf16x8 r; asm volatile("ds_read_b128 %0, %1 offset:%2" : "=&v"(r) : "v"(ka), "i"(OFF) : "memory"); return r; }
__device__ __forceinline__ int v_st(int k, int c) { const int kk = (k & ~0xC) | ((k & 4) << 1) | ((k & 8) >> 1); return ((kk >> 3) * 4 + (c >> 5)) * 512 + ((kk & 7) * 32 + (c & 31)) * 2; }
__device__ __forceinline__ int v_rd_base(int lane) { return ((lane & 3) << 3) | (((lane >> 2) & 3) << 6) | (((lane >> 4) & 1) << 5) | (((lane >> 5) & 1) << 8); }
constexpr int v_rd_off(int d0, int ks, int half) { return d0 * 512 + ks * 4096 + half * 2048; }
template <int OFF> __device__ __forceinline__ s16x4 tr_read(int vb) {
  s16x4 r; asm volatile("ds_read_b64_tr_b16 %0, %1 offset:%2" : "=&v"(r) : "v"(vb), "i"(OFF) : "memory"); return r;
}
struct VFrag { s16x4 l0, h0, l1, h1, l2, h2, l3, h3; };
template <int D0> __device__ __forceinline__ void v_load(VFrag& f, int vb) {
  f.l0 = tr_read<v_rd_off(D0, 0, 0)>(vb); f.h0 = tr_read<v_rd_off(D0, 0, 1)>(vb); f.l1 = tr_read<v_rd_off(D0, 1, 0)>(vb); f.h1 = tr_read<v_rd_off(D0, 1, 1)>(vb);
  f.l2 = tr_read<v_rd_off(D0, 2, 0)>(vb); f.h2 = tr_read<v_rd_off(D0, 2, 1)>(vb); f.l3 = tr_read<v_rd_off(D0, 3, 0)>(vb); f.h3 = tr_read<v_rd_off(D0, 3, 1)>(vb);
}
__device__ __forceinline__ void pv_mma(f32x16& od, const VFrag& f, bf16x8 pa0, bf16x8 pa1, bf16x8 pa2, bf16x8 pa3) {
#define PK(L, H) (bf16x8){L[0], L[1], L[2], L[3], H[0], H[1], H[2], H[3]}
  od = __builtin_amdgcn_mfma_f32_32x32x16_bf16(pa0, PK(f.l0, f.h0), od, 0, 0, 0);
  od = __builtin_amdgcn_mfma_f32_32x32x16_bf16(pa1, PK(f.l1, f.h1), od, 0, 0, 0);
  od = __builtin_amdgcn_mfma_f32_32x32x16_bf16(pa2, PK(f.l2, f.h2), od, 0, 0, 0);
  od = __builtin_amdgcn_mfma_f32_32x32x16_bf16(pa3, PK(f.l3, f.h3), od, 0, 0, 0);
#undef PK
}
template <int D0> __device__ __forceinline__ void pv_one(f32x16& od, int vb, bf16x8 pa0, bf16x8 pa1, bf16x8 pa2, bf16x8 pa3) {
  const s16x4 l0 = tr_read<v_rd_off(D0, 0, 0)>(vb), h0 = tr_read<v_rd_off(D0, 0, 1)>(vb), l1 = tr_read<v_rd_off(D0, 1, 0)>(vb), h1 = tr_read<v_rd_off(D0, 1, 1)>(vb);
  const s16x4 l2 = tr_read<v_rd_off(D0, 2, 0)>(vb), h2 = tr_read<v_rd_off(D0, 2, 1)>(vb), l3 = tr_read<v_rd_off(D0, 3, 0)>(vb), h3 = tr_read<v_rd_off(D0, 3, 1)>(vb);
  asm volatile("s_waitcnt lgkmcnt(0)" ::: "memory"); SBAR();
#define PK(L, H) (bf16x8){L[0], L[1], L[2], L[3], H[0], H[1], H[2], H[3]}
  od = __builtin_amdgcn_mfma_f32_32x32x16_bf16(pa0, PK(l0, h0), od, 0, 0, 0);
  od = __builtin_amdgcn_mfma_f32_32x32x16_bf16(pa1, PK(l1, h1), od, 0, 0, 0);
  od = __builtin_amdgcn_mfma_f32_32x32x16_bf16(pa2, PK(l2, h2), od, 0, 0, 0);
  od = __builtin_amdgcn_mfma_f32_32x32x16_bf16(pa3, PK(l3, h3), od, 0, 0, 0);
#undef PK
}
template <bool PIPE> __device__ __forceinline__ void pv_d0(f32x16* o, int vb, bf16x8 pa0, bf16x8 pa1, bf16x8 pa2, bf16x8 pa3) {
  if constexpr (!PIPE) { pv_one<0>(o[0], vb, pa0, pa1, pa2, pa3); pv_one<1>(o[1], vb, pa0, pa1, pa2, pa3); pv_one<2>(o[2], vb, pa0, pa1, pa2, pa3); pv_one<3>(o[3], vb, pa0, pa1, pa2, pa3); return; }
  VFrag A, B;
  v_load<0>(A, vb); v_load<1>(B, vb);
  asm volatile("s_waitcnt lgkmcnt(8)" ::: "memory"); SBAR(); pv_mma(o[0], A, pa0, pa1, pa2, pa3); SBAR();
  v_load<2>(A, vb);
  asm volatile("s_waitcnt lgkmcnt(8)" ::: "memory"); SBAR(); pv_mma(o[1], B, pa0, pa1, pa2, pa3); SBAR();
  v_load<3>(B, vb);
  asm volatile("s_waitcnt lgkmcnt(8)" ::: "memory"); SBAR(); pv_mma(o[2], A, pa0, pa1, pa2, pa3); SBAR();
  asm volatile("s_waitcnt lgkmcnt(0)" ::: "memory"); SBAR(); pv_mma(o[3], B, pa0, pa1, pa2, pa3);
}

template <typename TQ, bool BOUNDED>
__device__ __forceinline__ void attn_dense_body(const TQ* __restrict__ Qb, const bf16* __restrict__ Kh, const bf16* __restrict__ Vh,
                                                bf16* __restrict__ Ob, int seq, char* lds, const float* __restrict__ q_gain, const float* __restrict__ rope, int t0) {
  using St = Stage<bf16>; using SQ = Stage<TQ>;
  constexpr int SD = BOUNDED ? 1 : 2;
  int tid_ = threadIdx.x; asm volatile("" : "+v"(tid_));
  const int tid = tid_, wid = tid >> 6, lane = tid & 63, r32 = lane & 31, hi = lane >> 5;
  bf16* V_lds = (bf16*)lds; bf16* K_lds = (bf16*)(lds + 2 * SHM_V);
  float* ws = (float*)(lds + 2 * SHM_V + 2 * SHM_K) + wid * 64; float* li_l = ws; float* al_l = ws + 32;
  float m_reg = -1e30f, l_reg = 0; f32x16 o[4] = {}; bf16x8 qr[8];
  const TQ* Qw = Qb + (long)(wid * QBLK + r32) * LDQ + hi * 8;
#pragma unroll
  for (int d0 = 0; d0 < 8; ++d0) qr[d0] = SQ::tobf(SQ::ld8(Qw + d0 * 16));
  const int sr = tid >> 4, sc = (tid & 15) * 8, vst0 = v_st(sr, sc), vst1 = v_st(32 + sr, sc);
  const int vb0 = (int)(uintptr_t)V_lds + v_rd_base(lane);
  struct { typename St::T vs0, vs1, ks0, ks1; } sr_[SD];
#define SLOAD(i, k0) do { sr_[i].vs0 = St::ld8(&Vh[(long)((k0) + sr) * LDK + sc]); sr_[i].vs1 = St::ld8(&Vh[(long)((k0) + 32 + sr) * LDK + sc]); \
    sr_[i].ks0 = St::ld8(&Kh[(long)((k0) + sr) * LDK + sc]); sr_[i].ks1 = St::ld8(&Kh[(long)((k0) + 32 + sr) * LDK + sc]); } while (0)
#define SWRITE(b, i) do { *(bf16x8*)((char*)V_lds + (b) * SHM_V + vst0) = St::tobf(sr_[i].vs0);          \
    *(bf16x8*)((char*)V_lds + (b) * SHM_V + vst1) = St::tobf(sr_[i].vs1); int kc = sc * 2;               \
    *(bf16x8*)((char*)K_lds + (b) * SHM_K + KSWZ(sr, kc)) = St::tobf(sr_[i].ks0);                       \
    *(bf16x8*)((char*)K_lds + (b) * SHM_K + KSWZ(32 + sr, kc)) = St::tobf(sr_[i].ks1); } while (0)
#define SWAIT() do { if constexpr (SD == 2) asm volatile("s_waitcnt vmcnt(4)" ::: "memory"); else asm volatile("s_waitcnt vmcnt(0)" ::: "memory"); } while (0)
#define PSM(P0, P1, MN, AL) do { if constexpr (BOUNDED) partialSM_b(P0); else partialSM(P0, P1, m_reg, MN, AL); } while (0)
#define FSM(P0, P1, AL) do { if constexpr (BOUNDED) finishSM_b(P0, P1, l_reg, pa0, pa1, pa2, pa3); else finishSM(P0, P1, AL, l_reg, pa0, pa1, pa2, pa3); } while (0)
#define RESC(a) do { if constexpr (!BOUNDED) if (__any((a) < 1.f)) { if (hi == 0) al_l[r32] = (a); asm volatile("s_waitcnt lgkmcnt(0)" ::: "memory"); \
    for (int d = 0; d < 4; ++d) for (int r = 0; r < 16; ++r) o[d][r] *= al_l[crow(r, hi)]; } } while (0)
  f32x16 pA0, pA1, pB0, pB1; float mnA = 0.f, mnB = 0.f, alA = 1.f, alB = 1.f; bf16x8 pa0, pa1, pa2, pa3; const int NT = seq / KVBLK;
  constexpr int SE = 0, SO = SD - 1;
  SLOAD(SE, 0);
  { const int t = t0 + wid * QBLK + r32; float ss = 0.f;
#pragma unroll
    for (int d0 = 0; d0 < 8; ++d0)
#pragma unroll
      for (int j = 0; j < 8; ++j) { const float x = __uint_as_float(((unsigned)(unsigned short)qr[d0][j]) << 16); ss += x * x; }
    ss += __shfl_xor(ss, 32);
    const float rs = (1.f / sqrtf(ss * (1.f / D) + 1e-6f)) * (BOUNDED ? SCALE * 1.4426950408889634f : 1.0f);
#pragma unroll
    for (int a = 0; a < 2; ++a) { const int pos = a ? (t & 63) : (t >> 6);
#pragma unroll
      for (int e = 0; e < 2; ++e) { const int dA = 4 * a + e, dB = dA + 2;
        const float* cs = rope + (size_t)(pos * 32 + e * 16 + hi * 8) * 2; const float* gA = q_gain + dA * 16 + hi * 8; const float* gB = q_gain + dB * 16 + hi * 8;
        float oA[8], oB[8];
#pragma unroll
        for (int j = 0; j < 8; ++j) { const float xa = __uint_as_float(((unsigned)(unsigned short)qr[dA][j]) << 16) * rs * gA[j], xb = __uint_as_float(((unsigned)(unsigned short)qr[dB][j]) << 16) * rs * gB[j];
          const float c = cs[2 * j], sn = cs[2 * j + 1]; oA[j] = xa * c - xb * sn; oB[j] = xb * c + xa * sn; }
        u32x4 wA = {cvtpk(oA[0], oA[1]), cvtpk(oA[2], oA[3]), cvtpk(oA[4], oA[5]), cvtpk(oA[6], oA[7])}, wB = {cvtpk(oB[0], oB[1]), cvtpk(oB[2], oB[3]), cvtpk(oB[4], oB[5]), cvtpk(oB[6], oB[7])};
        qr[dA] = *reinterpret_cast<bf16x8*>(&wA); qr[dB] = *reinterpret_cast<bf16x8*>(&wB); } } }
  asm volatile("s_waitcnt vmcnt(0)" ::: "memory"); SWRITE(0, SE); __syncthreads();
  qkt(pA0, pA1, K_lds, qr, r32, hi); PSM(pA0, pA1, mnA, alA);
  SLOAD(SO, KVBLK); if constexpr (SD == 2) { if (2 < NT) SLOAD(SE, 2 * KVBLK); }
  SWAIT(); SWRITE(1, SO); __syncthreads();
  for (int j = 1; j + 1 < NT; j += 2) {
    SBAR(); qkt(pB0, pB1, (bf16*)((char*)K_lds + SHM_K), qr, r32, hi);
    FSM(pA0, pA1, alA); SBAR();
    SLOAD(SO, (j + SD) * KVBLK); SBAR();
    pv_d0<BOUNDED>(o, vb0, pa0, pa1, pa2, pa3); PSM(pB0, pB1, mnB, alB);
    __syncthreads(); SWAIT(); SWRITE(0, SE);
    RESC(alB); __syncthreads();
    SBAR(); qkt(pA0, pA1, K_lds, qr, r32, hi);
    FSM(pB0, pB1, alB); SBAR();
    if (SD == 1 || j + 3 < NT) SLOAD(SE, (j + 1 + SD) * KVBLK); SBAR();
    pv_d0<BOUNDED>(o, vb0 + (int)SHM_V, pa0, pa1, pa2, pa3); PSM(pA0, pA1, mnA, alA);
    __syncthreads(); SWAIT(); SWRITE(1, SO);
    RESC(alA); __syncthreads();
  }
  SBAR(); qkt(pB0, pB1, (bf16*)((char*)K_lds + SHM_K), qr, r32, hi);
  FSM(pA0, pA1, alA); SBAR();
  pv_d0<BOUNDED>(o, vb0, pa0, pa1, pa2, pa3); PSM(pB0, pB1, mnB, alB);
  __syncthreads(); RESC(alB);
  FSM(pB0, pB1, alB); SBAR();
  pv_d0<BOUNDED>(o, vb0 + (int)SHM_V, pa0, pa1, pa2, pa3);
  if (hi == 0) li_l[r32] = l_reg; asm volatile("s_waitcnt lgkmcnt(0)" ::: "memory");
  float rli[16];
#pragma unroll
  for (int r = 0; r < 16; ++r) rli[r] = __builtin_amdgcn_rcpf(li_l[crow(r, hi)]);
  __syncthreads();
  { int ln_ = (int)__builtin_amdgcn_mbcnt_hi(~0u, __builtin_amdgcn_mbcnt_lo(~0u, 0u)); asm volatile("" : "+v"(ln_));
    const int hi_ = ln_ >> 5, r32_ = ln_ & 31;
    char* wbase = lds + wid * 8192 + hi_ * 1024 + r32_ * 2;
#pragma unroll
    for (int r = 0; r < 16; ++r)
#pragma unroll
      for (int d0 = 0; d0 < 4; ++d0) *(unsigned short*)(wbase + ((r & 3) + 8 * (r >> 2)) * 256 + d0 * 64) = (unsigned short)(cvtpk(o[d0][r] * rli[r], 0.f) & 0xffffu);
    asm volatile("s_waitcnt lgkmcnt(0)" ::: "memory");
    const char* rbase = lds + wid * 8192 + (ln_ >> 4) * 256 + (ln_ & 15) * 16;
    unsigned short* Ow = (unsigned short*)Ob + (long)(wid * QBLK + (ln_ >> 4)) * LDO + (ln_ & 15) * 8;
#pragma unroll
    for (int j = 0; j < 8; ++j) *(u32x4*)(Ow + (long)(4 * j) * LDO) = *(const u32x4*)(rbase + j * 1024); }
#undef SLOAD
#undef SWRITE
#undef SWAIT
#undef RESC
#undef PSM
#undef FSM
}


using f32x4 = __attribute__((ext_vector_type(4))) float;
#define MF16(a, b, c) __builtin_amdgcn_mfma_f32_16x16x32_bf16(a, b, c, 0, 0, 0)
struct ST16 { f32x4 s[2][4]; };
struct KF16 { bf16x8 d0, d1, d2, d3; };
struct VF16 { s16x4 a0, a1, b0, b1; };
template <int OFF> __device__ __forceinline__ void kf_load(KF16& f, const int (&ka)[4]) { f.d0 = k_read<OFF>(ka[0]); f.d1 = k_read<OFF>(ka[1]); f.d2 = k_read<OFF>(ka[2]); f.d3 = k_read<OFF>(ka[3]); }
template <int OFF> __device__ __forceinline__ void vf_load(VF16& f, int vb) { f.a0 = tr_read<OFF>(vb); f.a1 = tr_read<OFF + 4096>(vb); f.b0 = tr_read<OFF + 8192>(vb); f.b1 = tr_read<OFF + 12288>(vb); }
__device__ __forceinline__ void qk_mma16(f32x4& s0, f32x4& s1, const KF16& f, const bf16x8 (&qr)[2][4]) {
  s0 = MF16(f.d0, qr[0][0], s0); s0 = MF16(f.d1, qr[0][1], s0); s0 = MF16(f.d2, qr[0][2], s0); s0 = MF16(f.d3, qr[0][3], s0); SBAR();
  s1 = MF16(f.d3, qr[1][3], s1); s1 = MF16(f.d2, qr[1][2], s1); s1 = MF16(f.d1, qr[1][1], s1); s1 = MF16(f.d0, qr[1][0], s1); SBAR();
}
__device__ __forceinline__ void pv_mma16(f32x4& o0, f32x4& o1, const VF16& f, const bf16x8 (&pa)[2][2]) {
#define PK(L, H) (bf16x8){L[0], L[1], L[2], L[3], H[0], H[1], H[2], H[3]}
  const bf16x8 v0 = PK(f.a0, f.a1), v1 = PK(f.b0, f.b1);
  o0 = MF16(pa[0][0], v0, o0); o0 = MF16(pa[0][1], v1, o0); SBAR(); o1 = MF16(pa[1][1], v1, o1); o1 = MF16(pa[1][0], v0, o1); SBAR();
#undef PK
}
__device__ __forceinline__ bf16x8 pack2_16(const f32x4& a, const f32x4& b) { u32x4 w = {cvtpk(a[0], a[1]), cvtpk(a[2], a[3]), cvtpk(b[0], b[1]), cvtpk(b[2], b[3])}; return *reinterpret_cast<bf16x8*>(&w); }
__device__ __forceinline__ void acc_l16(f32x2& l, const f32x4& a) { l += (f32x2){a[0], a[1]}; l += (f32x2){a[2], a[3]}; }
__device__ __forceinline__ void exp4_16(f32x4& a) { a[0] = __builtin_amdgcn_exp2f(a[0]); a[1] = __builtin_amdgcn_exp2f(a[1]); a[2] = __builtin_amdgcn_exp2f(a[2]); a[3] = __builtin_amdgcn_exp2f(a[3]); }
template <int G> __device__ __forceinline__ void fsm16(ST16& T, f32x2 (&l2)[2], bf16x8 (&pa)[2][2]) {
  if constexpr (G == 0) { pa[0][0] = pack2_16(T.s[0][0], T.s[0][1]); acc_l16(l2[0], T.s[0][0]); acc_l16(l2[0], T.s[0][1]); }
  else if constexpr (G == 1) { pa[1][0] = pack2_16(T.s[1][0], T.s[1][1]); acc_l16(l2[1], T.s[1][0]); acc_l16(l2[1], T.s[1][1]); }
  else if constexpr (G == 2) { pa[0][1] = pack2_16(T.s[0][2], T.s[0][3]); acc_l16(l2[0], T.s[0][2]); acc_l16(l2[0], T.s[0][3]); }
  else { pa[1][1] = pack2_16(T.s[1][2], T.s[1][3]); acc_l16(l2[1], T.s[1][2]); acc_l16(l2[1], T.s[1][3]); }
}
template <int KOFF, bool FSM, bool DMA> __device__ __forceinline__ void qk16(ST16& C, const int (&ka)[4], const bf16x8 (&qr)[2][4], ST16& P, f32x2 (&l2)[2], bf16x8 (&pa)[2][2],
                                                                          const bf16* kp, const bf16* vp, PG8_LAS unsigned char* dKb, PG8_LAS unsigned char* dVb) {
#define GLDS4(src, dst) __builtin_amdgcn_global_load_lds((const unsigned*)(src), (PG8_LAS unsigned*)(dst), 16, 0, 0)
  KF16 fa, fb;
#pragma unroll
  for (int qb = 0; qb < 2; ++qb)
#pragma unroll
    for (int kb = 0; kb < 4; ++kb) C.s[qb][kb] = (f32x4){0.f, 0.f, 0.f, 0.f};
  kf_load<KOFF>(fa, ka); kf_load<KOFF + 4096>(fb, ka);
  asm volatile("s_waitcnt lgkmcnt(4)" ::: "memory"); SBAR(); qk_mma16(C.s[0][0], C.s[1][0], fa, qr); if constexpr (FSM) fsm16<0>(P, l2, pa); kf_load<KOFF + 8192>(fa, ka); if constexpr (DMA) GLDS4(kp, dKb);
  asm volatile("s_waitcnt lgkmcnt(4)" ::: "memory"); SBAR(); qk_mma16(C.s[0][1], C.s[1][1], fb, qr); if constexpr (FSM) fsm16<1>(P, l2, pa); kf_load<KOFF + 12288>(fb, ka); if constexpr (DMA) GLDS4(kp + 32 * LDK, dKb + 8192);
  asm volatile("s_waitcnt lgkmcnt(4)" ::: "memory"); SBAR(); qk_mma16(C.s[0][2], C.s[1][2], fa, qr); if constexpr (FSM) fsm16<2>(P, l2, pa); if constexpr (DMA) GLDS4(vp, dVb);
  asm volatile("s_waitcnt lgkmcnt(0)" ::: "memory"); SBAR(); qk_mma16(C.s[0][3], C.s[1][3], fb, qr); if constexpr (FSM) fsm16<3>(P, l2, pa); if constexpr (DMA) GLDS4(vp + 32 * LDK, dVb + 8192);
#undef GLDS4
}
template <int VOFF, bool PEX> __device__ __forceinline__ void pv16(f32x4 (&o)[2][8], int vb, const bf16x8 (&pa)[2][2], ST16& C) {
  VF16 A0, A1, B0, B1;
  vf_load<VOFF>(A0, vb); vf_load<VOFF + 256>(A1, vb); vf_load<VOFF + 512>(B0, vb); vf_load<VOFF + 768>(B1, vb);
  asm volatile("s_waitcnt lgkmcnt(8)" ::: "memory"); SBAR(); pv_mma16(o[0][0], o[1][0], A0, pa); pv_mma16(o[0][1], o[1][1], A1, pa); if constexpr (PEX) { exp4_16(C.s[0][0]); exp4_16(C.s[1][0]); }
  vf_load<VOFF + 1024>(A0, vb); vf_load<VOFF + 1280>(A1, vb);
  asm volatile("s_waitcnt lgkmcnt(8)" ::: "memory"); SBAR(); pv_mma16(o[0][2], o[1][2], B0, pa); pv_mma16(o[0][3], o[1][3], B1, pa); if constexpr (PEX) { exp4_16(C.s[0][1]); exp4_16(C.s[1][1]); }
  vf_load<VOFF + 1536>(B0, vb); vf_load<VOFF + 1792>(B1, vb);
  asm volatile("s_waitcnt lgkmcnt(8)" ::: "memory"); SBAR(); pv_mma16(o[0][4], o[1][4], A0, pa); pv_mma16(o[0][5], o[1][5], A1, pa); if constexpr (PEX) { exp4_16(C.s[0][2]); exp4_16(C.s[1][2]); }
  asm volatile("s_waitcnt lgkmcnt(0)" ::: "memory"); SBAR(); pv_mma16(o[0][6], o[1][6], B0, pa); pv_mma16(o[0][7], o[1][7], B1, pa); if constexpr (PEX) { exp4_16(C.s[0][3]); exp4_16(C.s[1][3]); }
}
__device__ __forceinline__ void attn_body_c16(const bf16* __restrict__ Qb, const bf16* __restrict__ Kh, const bf16* __restrict__ Vh, bf16* __restrict__ Ob, char* lds, PG8_LAS unsigned char* ldsl,
                                              const float* __restrict__ q_gain, const float* __restrict__ rope, int t0) {
  using St = Stage<bf16>;
  int tid_ = threadIdx.x; asm volatile("" : "+v"(tid_));
  const int tid = tid_, wid = tid >> 6, lane = tid & 63, i16 = lane & 15, g = lane >> 4;
  bf16* V_lds = (bf16*)lds; bf16* K_lds = (bf16*)(lds + 4 * SHM_V);
  float* li_l = (float*)(lds + 4 * SHM_V + 3 * SHM_K) + wid * 64;
  f32x2 l2[2] = {{0.f, 0.f}, {0.f, 0.f}}; f32x4 o[2][8]; bf16x8 qr[2][4];
#pragma unroll
  for (int qb = 0; qb < 2; ++qb)
#pragma unroll
    for (int db = 0; db < 8; ++db) o[qb][db] = (f32x4){0.f, 0.f, 0.f, 0.f};
#pragma unroll
  for (int qb = 0; qb < 2; ++qb)
#pragma unroll
    for (int dc = 0; dc < 4; ++dc) qr[qb][dc] = St::ld8(Qb + (long)(wid * QBLK + qb * 16 + i16) * LDQ + dc * 32 + g * 8);
  int ka[4];
#pragma unroll
  for (int dc = 0; dc < 4; ++dc) ka[dc] = (int)(uintptr_t)K_lds + i16 * 256 + (((dc * 4 + g) ^ i16) << 4);
  const int vb0 = (int)(uintptr_t)V_lds + (g >> 1) * 2048 + (g & 1) * 128 + (i16 >> 2) * 32 + (i16 & 3) * 8;
  const int wu = __builtin_amdgcn_readfirstlane(wid);
  const int krow = 4 * wid + (lane >> 4);
  const unsigned koff = (unsigned)(krow * LDK + (((lane & 15) ^ (krow & 15)) << 3));
  const unsigned voff = (unsigned)(((wid >> 1) * 8 + ((lane >> 1) & 7)) * LDK + ((wid & 1) * 4 + (lane >> 4)) * 16 + (lane & 1) * 8);
  PG8_LAS unsigned char* const dV = ldsl + wu * 1024; PG8_LAS unsigned char* const dK = ldsl + 4 * SHM_V + wu * 1024;
#define GLDS4(src, dst) __builtin_amdgcn_global_load_lds((const unsigned*)(src), (PG8_LAS unsigned*)(dst), 16, 0, 0)
  const bf16* kp_ = Kh + koff; const bf16* vp_ = Vh + voff;
#define SDMA(kb, vb, ADV) do { GLDS4(kp_, dK + (kb) * SHM_K); GLDS4(kp_ + 32 * LDK, dK + (kb) * SHM_K + 8192); GLDS4(vp_, dV + (vb) * SHM_V); GLDS4(vp_ + 32 * LDK, dV + (vb) * SHM_V + 8192); \
    const int adv_ = (ADV) ? KVBLK * LDK : 0; kp_ += adv_; vp_ += adv_; asm volatile("" : "+v"(kp_), "+v"(vp_)); } while (0)
#define WBAR(n) do { asm volatile("s_waitcnt vmcnt(" #n ") lgkmcnt(0)" ::: "memory"); SBAR(); __builtin_amdgcn_s_barrier(); SBAR(); } while (0)
  ST16 TA, TB; bf16x8 pa[2][2];
  SDMA(0, 0, true);
  { f32x4 gq[2][4], cq[2][2][4];
#pragma unroll
    for (int a = 0; a < 2; ++a) { const float* gA = q_gain + a * 64 + g * 8; gq[a][0] = *(const f32x4*)gA; gq[a][1] = *(const f32x4*)(gA + 4); gq[a][2] = *(const f32x4*)(gA + 32); gq[a][3] = *(const f32x4*)(gA + 36); }
#pragma unroll
    for (int qb = 0; qb < 2; ++qb) { const int t = t0 + wid * QBLK + qb * 16 + i16;
#pragma unroll
      for (int a = 0; a < 2; ++a) { const int pos = a ? (t & 63) : (t >> 6); const float* cs = rope + (size_t)(pos * 32 + g * 8) * 2;
#pragma unroll
        for (int k = 0; k < 4; ++k) cq[qb][a][k] = *(const f32x4*)(cs + 4 * k); } }
#pragma unroll
    for (int qb = 0; qb < 2; ++qb) {
      float ss = 0.f;
#pragma unroll
      for (int dc = 0; dc < 4; ++dc)
#pragma unroll
        for (int j = 0; j < 8; ++j) { const float x = __uint_as_float(((unsigned)(unsigned short)qr[qb][dc][j]) << 16); ss += x * x; }
      ss += __shfl_xor(ss, 16); ss += __shfl_xor(ss, 32);
      const float rs = (1.f / sqrtf(ss * (1.f / D) + 1e-6f)) * (SCALE * 1.4426950408889634f);
#pragma unroll
      for (int a = 0; a < 2; ++a) {
        float oA[8], oB[8];
#pragma unroll
        for (int j = 0; j < 8; ++j) { const float xa = __uint_as_float(((unsigned)(unsigned short)qr[qb][2 * a][j]) << 16) * rs * gq[a][j >> 2][j & 3], xb = __uint_as_float(((unsigned)(unsigned short)qr[qb][2 * a + 1][j]) << 16) * rs * gq[a][2 + (j >> 2)][j & 3];
          const float c = cq[qb][a][j >> 1][2 * (j & 1)], sn = cq[qb][a][j >> 1][2 * (j & 1) + 1]; oA[j] = xa * c - xb * sn; oB[j] = xb * c + xa * sn; }
        u32x4 wA = {cvtpk(oA[0], oA[1]), cvtpk(oA[2], oA[3]), cvtpk(oA[4], oA[5]), cvtpk(oA[6], oA[7])}, wB = {cvtpk(oB[0], oB[1]), cvtpk(oB[2], oB[3]), cvtpk(oB[4], oB[5]), cvtpk(oB[6], oB[7])};
        qr[qb][2 * a] = *reinterpret_cast<bf16x8*>(&wA); qr[qb][2 * a + 1] = *reinterpret_cast<bf16x8*>(&wB); } } }
  SDMA(1, 1, true);
  WBAR(4);
  SDMA(2, 2, true); SBAR();
  qk16<0, false, false>(TA, ka, qr, TB, l2, pa, kp_, vp_, dK, dV);
  exp4_16(TA.s[0][0]); exp4_16(TA.s[0][1]); exp4_16(TA.s[1][0]); exp4_16(TA.s[1][1]); exp4_16(TA.s[0][2]); exp4_16(TA.s[0][3]); exp4_16(TA.s[1][2]); exp4_16(TA.s[1][3]);
  WBAR(4);
#define STEP16(J, T) do { \
    SBAR(); \
    if ((J) & 1) { qk16<(((J) + 1) % 3) * (int)SHM_K, true, true>(TA, ka, qr, TB, l2, pa, kp_, vp_, dK + ((J) % 3) * SHM_K, dV + (((J) + 3) % 4) * SHM_V); } \
    else         { qk16<(((J) + 1) % 3) * (int)SHM_K, true, true>(TB, ka, qr, TA, l2, pa, kp_, vp_, dK + ((J) % 3) * SHM_K, dV + (((J) + 3) % 4) * SHM_V); } \
    { const int adv_ = ((T) + 2 < 68) ? KVBLK * LDK : 0; kp_ += adv_; vp_ += adv_; asm volatile("" : "+v"(kp_), "+v"(vp_)); } SBAR(); \
    if ((J) & 1) { pv16<((J) % 4) * (int)SHM_V, true>(o, vb0, pa, TA); } else { pv16<((J) % 4) * (int)SHM_V, true>(o, vb0, pa, TB); } \
    WBAR(4); } while (0)
  if (wu >= 4) __builtin_amdgcn_s_setprio(1);
  STEP16(0, 1); STEP16(1, 2); STEP16(2, 3); STEP16(3, 4); STEP16(4, 5); STEP16(5, 6); STEP16(6, 7);
  for (int t = 8; t < 68; t += 12) {
    STEP16(7, t); STEP16(8, t + 1); STEP16(9, t + 2); STEP16(10, t + 3); STEP16(11, t + 4);
    STEP16(0, t + 5); STEP16(1, t + 6); STEP16(2, t + 7); STEP16(3, t + 8); STEP16(4, t + 9); STEP16(5, t + 10); STEP16(6, t + 11);
  }
#undef STEP16
  __builtin_amdgcn_s_setprio(0);
  fsm16<0>(TB, l2, pa); fsm16<1>(TB, l2, pa); fsm16<2>(TB, l2, pa); fsm16<3>(TB, l2, pa); SBAR();
  pv16<3 * (int)SHM_V, false>(o, vb0, pa, TB);
  float rli[2][4];
  { float l0 = l2[0][0] + l2[0][1], l1 = l2[1][0] + l2[1][1];
    l0 += __shfl_xor(l0, 16); l0 += __shfl_xor(l0, 32); l1 += __shfl_xor(l1, 16); l1 += __shfl_xor(l1, 32);
    if (g == 0) { li_l[i16] = l0; li_l[16 + i16] = l1; } asm volatile("s_waitcnt lgkmcnt(0)" ::: "memory");
#pragma unroll
    for (int qb = 0; qb < 2; ++qb)
#pragma unroll
      for (int r = 0; r < 4; ++r) rli[qb][r] = __builtin_amdgcn_rcpf(li_l[qb * 16 + 4 * g + r]); }
  __syncthreads();
  { int ln_ = (int)__builtin_amdgcn_mbcnt_hi(~0u, __builtin_amdgcn_mbcnt_lo(~0u, 0u)); asm volatile("" : "+v"(ln_));
    char* wbase = lds + wid * 8192 + (ln_ >> 4) * 1024 + (ln_ & 15) * 2;
#pragma unroll
    for (int qb = 0; qb < 2; ++qb)
#pragma unroll
      for (int db = 0; db < 8; ++db)
#pragma unroll
        for (int r = 0; r < 4; ++r) *(unsigned short*)(wbase + (qb * 16 + r) * 256 + db * 32) = (unsigned short)(cvtpk(o[qb][db][r] * rli[qb][r], 0.f) & 0xffffu);
    asm volatile("s_waitcnt lgkmcnt(0)" ::: "memory");
    const char* rbase = lds + wid * 8192 + (ln_ >> 4) * 256 + (ln_ & 15) * 16;
    unsigned short* Ow = (unsigned short*)Ob + (long)(wid * QBLK + (ln_ >> 4)) * LDO + (ln_ & 15) * 8;
#pragma unroll
    for (int j = 0; j < 8; ++j) *(u32x4*)(Ow + (long)(4 * j) * LDO) = *(const u32x4*)(rbase + j * 1024); }
#undef WBAR
#undef SDMA
#undef GLDS4
}
#undef MF16
#undef KSWZ
#undef SBAR
}

constexpr int DM = 4096, NB = 4, SEQ = 4096, CTXL = 256, ML = NB * SEQ, MC = NB * CTXL, MT = ML + MC, FF = 16384;
constexpr int HQ = 32, HKV = 8, HD = 128, KVD = HKV * HD, NQKV = DM + 2 * KVD, SKV = SEQ + CTXL, NMOD = 6;
constexpr float LN_EPS = 1e-5f, RMS_EPS = 1e-6f, ALPHA = 1.4142135623730951f;
constexpr int NWAVES = 8;
static_assert(attn::HQ * attn::D == DM && attn::HKV * attn::D == KVD && SKV == 68 * 64, "attention strides; attn_body_b3 is unrolled for 68 key tiles");

constexpr size_t MiB = 1u << 20;
constexpr size_t WS_CTL = 0, CTL_ZERO_BYTES = 32768;
constexpr size_t WS_MOD = 1 * MiB;
constexpr size_t WS_ROPE = 2 * MiB;
constexpr size_t WS_WCI = 4 * MiB, WS_WCO = 100 * MiB, WS_W1A = 132 * MiB, WS_W2A = 260 * MiB, WS_WQKV = 388 * MiB, WS_WO = 436 * MiB, WS_W1B = 468 * MiB, WS_W2B = 596 * MiB;
constexpr size_t WS_A = 724 * MiB;
constexpr size_t WS_ZF = 860 * MiB;
constexpr size_t WS_Y = 1132 * MiB;
constexpr size_t WS_YS = 1268 * MiB;
constexpr size_t WS_SLAB = 1300 * MiB;
constexpr size_t WS_STATS = 3 * MiB;
constexpr size_t WS_BIG = 1404 * MiB;
constexpr size_t WS_GB = WS_BIG, WS_U = WS_BIG + 136 * MiB, WS_Z = WS_BIG + 272 * MiB;
constexpr size_t WS_Q = WS_BIG, WS_K = WS_BIG + 128 * MiB, WS_V = WS_K + 34 * MiB, WS_O = WS_V + 34 * MiB;
constexpr size_t WS_END = WS_BIG + 544 * MiB;
static_assert(WS_WCI + (size_t)3 * DM * DM * 2 <= WS_WCO && WS_W1A + (size_t)DM * FF * 2 <= WS_W2A && WS_WQKV + (size_t)NQKV * DM * 2 <= WS_WO && WS_W2B + (size_t)DM * FF * 2 <= WS_A, "weights map");
static_assert(WS_A + (size_t)MT * DM * 2 <= WS_ZF && WS_ZF + (size_t)MT * DM * 4 <= WS_Y && WS_Y + (size_t)MT * DM * 2 <= WS_YS && WS_YS + (size_t)3 * MC * DM * 2 <= WS_SLAB && WS_SLAB + (size_t)8 * MC * 2048 * 4 <= WS_BIG && WS_BIG + (size_t)MT * FF * 2 <= WS_END, "activation map");
static_assert(WS_Z + (size_t)MT * DM * 2 <= WS_END && WS_K + (size_t)NB * SKV * KVD * 2 <= WS_V && WS_O + (size_t)ML * DM * 2 <= WS_END && WS_Q + (size_t)ML * DM * 2 <= WS_K, "overlay map");
constexpr int CW_BAR = 4096;
static_assert((CW_BAR + 3456) * 4 <= (int)CTL_ZERO_BYTES, "barrier words inside the per-call memset");

constexpr int RING_OFF = 0, RING_BYTES = 131072;
constexpr int LDSCTL_OFF = RING_BYTES, MISC_OFF = LDSCTL_OFF + 320;
constexpr int LDS_BYTES = 147456;
static_assert(MISC_OFF + 128 <= LDS_BYTES && (int)attn::SHM_ATTN <= RING_BYTES, "LDS map");

#define GAS __attribute__((address_space(1)))
#define LAS __attribute__((address_space(3)))
typedef unsigned short bf16;
typedef unsigned v4u __attribute__((ext_vector_type(4)));
typedef unsigned v2u __attribute__((ext_vector_type(2)));
typedef float f32x4 __attribute__((ext_vector_type(4)));
typedef GAS unsigned gu32;
#define RLX_AGENT __ATOMIC_RELAXED, __HIP_MEMORY_SCOPE_AGENT
#define LDS_WAIT() asm volatile("s_waitcnt lgkmcnt(0)" ::: "memory")
#define VM_WAIT() asm volatile("s_waitcnt vmcnt(0)" ::: "memory")
__device__ __forceinline__ unsigned f2bf(float f) { unsigned u = __builtin_bit_cast(unsigned, f); return (u + 0x7fffu + ((u >> 16) & 1u)) >> 16; }
__device__ __forceinline__ unsigned pk2(float lo, float hi) { return f2bf(lo) | (f2bf(hi) << 16); }
typedef float f32x2_t __attribute__((ext_vector_type(2)));
typedef _Float16 f16x2_t __attribute__((ext_vector_type(2)));
__device__ __forceinline__ unsigned pkh2(float lo, float hi) { const f32x2_t v = {lo, hi}; return __builtin_bit_cast(unsigned, __builtin_convertvector(v, f16x2_t)); }
__device__ __forceinline__ float hlo(unsigned w) { return (float)__builtin_bit_cast(f16x2_t, w).x; }
__device__ __forceinline__ float hhi(unsigned w) { return (float)__builtin_bit_cast(f16x2_t, w).y; }
__device__ __forceinline__ float bflo(unsigned w) { return __builtin_bit_cast(float, w << 16); }
__device__ __forceinline__ float bfhi(unsigned w) { return __builtin_bit_cast(float, w & 0xffff0000u); }

#define XB_TMO      128
#define XB_XCNT(j)  (256  + 64 * (j))
#define XB_XSUB(j)  (1280 + 64 * (j))
#define XB_XGEN(j)  (2304 + 64 * (j))
#define XB_TOP      3328
#define XB_TOPGEN   3392
#define XCD_BAR_WORDS 3456
#define XB_SPIN_CAP (1u << 18)

__device__ __forceinline__ unsigned xb_ld(unsigned* p)              { return __hip_atomic_load(p, __ATOMIC_RELAXED, __HIP_MEMORY_SCOPE_AGENT); }
__device__ __forceinline__ unsigned xb_add(unsigned* p, unsigned v) { return __hip_atomic_fetch_add(p, v, __ATOMIC_RELAXED, __HIP_MEMORY_SCOPE_AGENT); }
__device__ __forceinline__ unsigned xb_xcc_id() { return (unsigned)__builtin_amdgcn_s_getreg((3 << 11) | 20) & 0xFu; }
#define XB_SPIN(cond, bar) do { unsigned _sp = 0; while (cond) { __builtin_amdgcn_s_sleep(1); \
    if ((++_sp & 255u) == 0u) { if (xb_ld(&(bar)[XB_TMO])) break; if (_sp > XB_SPIN_CAP) { atomicAdd(&(bar)[XB_TMO], 1u); break; } } } } while (0)

struct XcdBarrier {
    unsigned* bar; unsigned x;
    volatile LAS unsigned* st;
};

__device__ __forceinline__ XcdBarrier xcd_barrier_post(unsigned* bar, volatile LAS unsigned* st) {
    XcdBarrier b; b.bar = bar; b.x = xb_xcc_id(); b.st = st;
    if (threadIdx.x == 0) (void)xb_add(&bar[XB_XCNT(b.x)], 1u);
    return b;
}
__device__ __forceinline__ void xcd_barrier_complete(unsigned* bar, unsigned x, unsigned& nloc, unsigned& nx) {
    const unsigned G = gridDim.x * gridDim.y * gridDim.z;
    unsigned sum, cnt, mine, sp = 0u;
    for (;;) {
        sum = 0u; cnt = 0u; mine = 0u;
#pragma unroll
        for (unsigned j = 0; j < 16; ++j) { const unsigned c = xb_ld(&bar[XB_XCNT(j)]); sum += c; cnt += (c > 0u) ? 1u : 0u; mine = (j == x) ? c : mine; }
        if (sum == G) break;
        __builtin_amdgcn_s_sleep(1);
        if ((++sp & 255u) == 0u) { if (xb_ld(&bar[XB_TMO])) break; if (sp > XB_SPIN_CAP) { atomicAdd(&bar[XB_TMO], 1u); break; } }
    }
    nloc = mine > 0u ? mine : 1u; nx = cnt > 0u ? cnt : 1u;
}

__device__ __forceinline__ void xcd_barrier(const XcdBarrier& b) {
    asm volatile("s_waitcnt vmcnt(0)" ::: "memory");
    __syncthreads();
    if (threadIdx.x == 0) {
        unsigned* bar = b.bar;
        __builtin_amdgcn_s_waitcnt(0);
        unsigned nloc = b.st[0], nx = b.st[1];
        if (nloc == 0u) { xcd_barrier_complete(bar, b.x, nloc, nx); b.st[0] = nloc; b.st[1] = nx; }
        const unsigned old = xb_add(&bar[XB_XSUB(b.x)], 1u);
        const unsigned gen = old / nloc;
        if (old + 1u == (gen + 1u) * nloc) {
            __builtin_amdgcn_fence(__ATOMIC_RELEASE, "agent");
            asm volatile("s_waitcnt vmcnt(0)" ::: "memory");
            const unsigned og = xb_add(&bar[XB_TOP], 1u);
            const unsigned tg = og / nx;
            if (og + 1u == (tg + 1u) * nx) xb_add(&bar[XB_TOPGEN], 1u);
            else XB_SPIN(xb_ld(&bar[XB_TOPGEN]) == tg, bar);
            __builtin_amdgcn_fence(__ATOMIC_ACQUIRE, "agent");
            xb_add(&bar[XB_XGEN(b.x)], 1u);
            asm volatile("s_waitcnt vmcnt(0)" ::: "memory");
        } else {
            XB_SPIN(xb_ld(&bar[XB_XGEN(b.x)]) == gen, bar);
            __builtin_amdgcn_fence(__ATOMIC_ACQUIRE, "agent");
            asm volatile("s_waitcnt vmcnt(0)" ::: "memory");
        }
    }
    __syncthreads();
}


struct Frame {
    LAS unsigned char* lds;
    volatile LAS unsigned* MISC;
    int tid, wave, vcu, G;
    const float *x, *c, *ctx, *cctx, *ada_w, *ada_b, *ln_g, *ln_b, *mlp_w1, *mlp_w2, *conv_in_w, *conv_w, *conv_b, *conv_out_w, *qkv_w, *q_gain, *k_gain, *out_w;
    float* out;
    float *mod, *rope, *ZF, *slab, *stats;
    bf16 *Wci, *Wco, *W1a, *W2a, *Wqkv, *Wo, *W1b, *W2b, *A, *BIG, *GB, *U, *Z, *Q, *K, *V, *O, *Y, *YS;
};
template <int OFF> __device__ __forceinline__ unsigned long long karg64(int tok) {
    unsigned long long v; asm("s_load_dwordx2 %0, %1, %3 ; %2\n\ts_waitcnt lgkmcnt(0)" : "=s"(v) : "s"(__builtin_amdgcn_kernarg_segment_ptr()), "s"(tok), "n"(OFF)); return v; }
template <int K> __device__ __forceinline__ const float* karg_in(int tok) { return (const float*)(const GAS float*)karg64<8 * K>(tok); }
__device__ __forceinline__ void load_ptrs(Frame& F, int tok) {
    F.x = karg_in<0>(tok); F.c = karg_in<1>(tok); F.ctx = karg_in<2>(tok); F.cctx = karg_in<3>(tok); F.ada_w = karg_in<4>(tok); F.ada_b = karg_in<5>(tok); F.ln_g = karg_in<6>(tok); F.ln_b = karg_in<7>(tok);
    F.mlp_w1 = karg_in<8>(tok); F.mlp_w2 = karg_in<9>(tok); F.conv_in_w = karg_in<10>(tok); F.conv_w = karg_in<11>(tok); F.conv_b = karg_in<12>(tok); F.conv_out_w = karg_in<13>(tok);
    F.qkv_w = karg_in<14>(tok); F.q_gain = karg_in<15>(tok); F.k_gain = karg_in<16>(tok); F.out_w = karg_in<17>(tok); F.out = (float*)(GAS float*)karg64<144>(tok);
    unsigned char* ws = (unsigned char*)(GAS unsigned char*)karg64<152>(tok);
    F.mod = (float*)(ws + WS_MOD); F.rope = (float*)(ws + WS_ROPE); F.ZF = (float*)(ws + WS_ZF); F.slab = (float*)(ws + WS_SLAB); F.stats = (float*)(ws + WS_STATS);
    F.Wci = (bf16*)(ws + WS_WCI); F.Wco = (bf16*)(ws + WS_WCO); F.W1a = (bf16*)(ws + WS_W1A); F.W2a = (bf16*)(ws + WS_W2A); F.Wqkv = (bf16*)(ws + WS_WQKV); F.Wo = (bf16*)(ws + WS_WO);
    F.W1b = (bf16*)(ws + WS_W1B); F.W2b = (bf16*)(ws + WS_W2B); F.A = (bf16*)(ws + WS_A); F.BIG = (bf16*)(ws + WS_BIG); F.GB = (bf16*)(ws + WS_GB); F.U = (bf16*)(ws + WS_U); F.Z = (bf16*)(ws + WS_Z);
    F.Q = (bf16*)(ws + WS_Q); F.K = (bf16*)(ws + WS_K); F.V = (bf16*)(ws + WS_V); F.O = (bf16*)(ws + WS_O); F.Y = (bf16*)(ws + WS_Y); F.YS = (bf16*)(ws + WS_YS);
}
#define PH_BEGIN Frame F = F0; { int tok_; asm volatile("s_mov_b32 %0, 0" : "=s"(tok_)); load_ptrs(F, tok_); }
__device__ __forceinline__ int lane_id() { return (int)__builtin_amdgcn_mbcnt_hi(~0u, __builtin_amdgcn_mbcnt_lo(~0u, 0u)); }
__device__ __forceinline__ int tid_id() { return (int)threadIdx.x; }
__device__ __forceinline__ float wave_sum(float v) {
#pragma unroll
    for (int o = 1; o < 64; o <<= 1) v += __shfl_xor(v, o);
    return v;
}

__device__ __forceinline__ void p0_adaln(Frame& F) {
    LAS float* sl = (LAS float*)(F.lds + RING_OFF);
    LAS float* red = (LAS float*)(F.lds + RING_OFF + 81920);
    for (int i = tid_id(); i < 5 * DM; i += NWAVES * 64) { const int s = i >> 12, k = i & 4095; const float v = s < 4 ? F.c[s * DM + k] : F.cctx[k]; sl[i] = v / (1.f + __expf(-v)); }
    __syncthreads();
    const int rr = lane_id() >> 4, c4 = lane_id() & 15;
    for (int it = F.vcu; it < 2 * 384; it += F.G) {
        const int l = it / 384, cc = it % 384;
        const float* wp = F.ada_w + (size_t)l * DM * (NMOD * DM) + (size_t)(4 * F.wave + rr) * (NMOD * DM) + cc * 64 + c4 * 4;
        float acc[5][4];
#pragma unroll
        for (int s = 0; s < 5; ++s)
#pragma unroll
            for (int j = 0; j < 4; ++j) acc[s][j] = 0.f;
        for (int i = 0; i < 128; i += 8) {
            f32x4 w[8];
#pragma unroll
            for (int u = 0; u < 8; ++u) w[u] = *(const f32x4*)(wp + (size_t)(32 * (i + u)) * (NMOD * DM));
#pragma unroll
            for (int u = 0; u < 8; ++u) { const int k = 4 * F.wave + rr + 32 * (i + u);
#pragma unroll
                for (int s = 0; s < 5; ++s) { const float a = sl[s * DM + k];
#pragma unroll
                    for (int j = 0; j < 4; ++j) acc[s][j] += a * w[u][j]; } }
        }
#pragma unroll
        for (int s = 0; s < 5; ++s)
#pragma unroll
            for (int j = 0; j < 4; ++j) { float v = acc[s][j]; v += __shfl_xor(v, 16); v += __shfl_xor(v, 32); acc[s][j] = v; }
        if (lane_id() < 16) {
#pragma unroll
            for (int s = 0; s < 5; ++s)
#pragma unroll
                for (int j = 0; j < 4; ++j) red[(F.wave * 5 + s) * 64 + c4 * 4 + j] = acc[s][j];
        }
        __syncthreads();
        const int t320 = tid_id(); if (t320 < 320) { const int s = t320 >> 6, col = t320 & 63; float v = 0.f;
#pragma unroll
            for (int w = 0; w < 8; ++w) v += red[(w * 5 + s) * 64 + col];
            F.mod[(size_t)(l * 5 + s) * (NMOD * DM) + cc * 64 + col] = v + F.ada_b[l * (NMOD * DM) + cc * 64 + col]; }
        __syncthreads();
    }
}
template <int MODE>
__device__ __forceinline__ void p0_transpose_item(const float* W, int K, int N, bf16* WT, LAS float* scr, int item, int lane) {
    const int nblk = N / 32, kb = item / nblk, nb = item % nblk, k0 = 64 * kb, n0 = 32 * nb;
    int d0 = n0;
    if (MODE == 1) { if (n0 >= 8192) { const int j = n0 - 8192; d0 = 4096 + (j >> 7) * 256 + 128 + (j & 127); } else if (n0 >= 4096) { const int j = n0 - 4096; d0 = 4096 + (j >> 7) * 256 + (j & 127); } }
#pragma unroll 8
    for (int i = 0; i < 32; ++i) { const int kk = 2 * i + (lane >> 5); scr[kk * 33 + (lane & 31)] = W[(size_t)(k0 + kk) * N + n0 + (lane & 31)]; }
    LDS_WAIT(); asm volatile("" ::: "memory");
    const int c = lane & 7;
#pragma unroll
    for (int j = 0; j < 4; ++j) { const int n = (lane >> 3) + 8 * j; const LAS float* s = scr + (8 * c) * 33 + n;
        v4u o; o.x = pk2(s[0 * 33], s[1 * 33]); o.y = pk2(s[2 * 33], s[3 * 33]); o.z = pk2(s[4 * 33], s[5 * 33]); o.w = pk2(s[6 * 33], s[7 * 33]);
        *(GAS v4u*)(WT + (size_t)(d0 + n) * K + k0 + 8 * c) = o; }
    LDS_WAIT(); asm volatile("" ::: "memory");
}
__device__ __forceinline__ void p0_weights(Frame& F) {
    LAS float* scr = (LAS float*)(F.lds + RING_OFF + F.wave * 16384);
    const int gw = F.vcu * NWAVES + F.wave, NGW = F.G * NWAVES;
    constexpr int I_CI = (DM / 64) * (3 * DM / 32), I_SQ = (DM / 64) * (DM / 32), I_W1 = (DM / 64) * (FF / 32), I_W2 = (FF / 64) * (DM / 32), I_QKV = (DM / 64) * (NQKV / 32);
    constexpr int NITEMS = I_CI + I_SQ + 2 * I_W1 + 2 * I_W2 + I_QKV + I_SQ;
    for (int it = gw; it < NITEMS; it += NGW) {
        int r = it;
        if (r < I_CI) { p0_transpose_item<1>(F.conv_in_w, DM, 3 * DM, F.Wci, scr, r, lane_id()); continue; } r -= I_CI;
        if (r < I_SQ) { p0_transpose_item<0>(F.conv_out_w, DM, DM, F.Wco, scr, r, lane_id()); continue; } r -= I_SQ;
        if (r < I_W1) { p0_transpose_item<0>(F.mlp_w1, DM, FF, F.W1a, scr, r, lane_id()); continue; } r -= I_W1;
        if (r < I_W2) { p0_transpose_item<0>(F.mlp_w2, FF, DM, F.W2a, scr, r, lane_id()); continue; } r -= I_W2;
        if (r < I_QKV) { p0_transpose_item<0>(F.qkv_w, DM, NQKV, F.Wqkv, scr, r, lane_id()); continue; } r -= I_QKV;
        if (r < I_SQ) { p0_transpose_item<0>(F.out_w, DM, DM, F.Wo, scr, r, lane_id()); continue; } r -= I_SQ;
        if (r < I_W1) { p0_transpose_item<0>(F.mlp_w1 + (size_t)DM * FF, DM, FF, F.W1b, scr, r, lane_id()); continue; } r -= I_W1;
        p0_transpose_item<0>(F.mlp_w2 + (size_t)DM * FF, FF, DM, F.W2b, scr, r, lane_id());
    }
    if (F.vcu == F.G - 1) {
        for (int i = tid_id(); i < 64 * 32; i += NWAVES * 64) { const int pos = i >> 5, f = i & 31;
            const float inv = exp2f(-(float)(2 * f) * (13.287712379549449f / 64.f));
            const float ang = (float)pos * inv;
            const float n = rintf(ang * 0.15915494309189535f);
            float r = fmaf(-n, 6.28125f, ang); r = fmaf(-n, 1.9353071795864769e-3f, r);
            F.rope[2 * i] = cosf(r); F.rope[2 * i + 1] = sinf(r); }
    }
}
__device__ __forceinline__ void p1_modulate(Frame& F) {
    LAS float* Vf = (LAS float*)(F.lds + RING_OFF);
    const int RB = (MT + F.G - 1) / F.G, r_begin = F.vcu * RB, r_end = (r_begin + RB < MT) ? r_begin + RB : MT;
    const int lane = lane_id();
    for (int ra = r_begin; ra < r_end;) {
        const int set = ra < ML ? (ra >> 12) : 4;
        int seg_end = ra < ML ? (((ra >> 12) + 1) << 12) : MT; if (seg_end > r_end) seg_end = r_end;
        __syncthreads();
        { const float* sh = F.mod + (size_t)(set * 6 + 0) * DM; const float* sc = sh + DM;
          for (int i = tid_id(); i < DM; i += NWAVES * 64) { Vf[i] = 1.0f + sc[i]; Vf[DM + i] = sh[i]; } }
        __syncthreads();
        const LAS f32x4* V = (const LAS f32x4*)Vf + lane;
        for (int r = ra + F.wave; r < seg_end; r += NWAVES) {
            const GAS f32x4* xr = (const GAS f32x4*)(r < ML ? F.x + (size_t)r * DM : F.ctx + (size_t)(r - ML) * DM) + lane;
            GAS v2u* o8 = (GAS v2u*)(F.A + (size_t)r * DM) + lane;
            f32x4 v[16];
#pragma unroll
            for (int j = 0; j < 16; ++j) v[j] = xr[64 * j];
#pragma unroll
            for (int j = 0; j < 16; ++j) { const f32x4 a = v[j] * V[64 * j] + V[1024 + 64 * j]; v2u w; w.x = pk2(a.x, a.y); w.y = pk2(a.z, a.w); o8[64 * j] = w; }
        }
        ra = seg_end;
    }
    __syncthreads();
}
#ifndef ZF16
#define ZF16 1
#endif
template <int MODE>
__device__ __forceinline__ void stage_rows(Frame& F, int nrows, const float* g_old, const float* b_old, const float* gate0, const float* g_new, const float* b_new, const float* shift0, int nslab) {
    LAS float* Vf = (LAS float*)(F.lds + RING_OFF);
    const int RB = (nrows + F.G - 1) / F.G, r_begin = F.vcu * RB, r_end = (r_begin + RB < nrows) ? r_begin + RB : nrows;
    const int lane = lane_id();
    for (int ra = r_begin; ra < r_end;) {
        const int set = ra < ML ? (ra >> 12) : 4;
        int seg_end = ra < ML ? (((ra >> 12) + 1) << 12) : nrows; if (seg_end > r_end) seg_end = r_end;
        __syncthreads();
        { const float* gate = gate0 + (size_t)set * 6 * DM; const float* sh = shift0 + (size_t)set * 6 * DM; const float* sc = sh + DM;
          for (int i = tid_id(); i < DM; i += NWAVES * 64) {
              if (MODE != 0) { Vf[i] = ALPHA * g_old[i]; Vf[DM + i] = ALPHA * b_old[i]; }
              Vf[2 * DM + i] = gate[i];
              if (MODE != 2) { const float s1 = 1.0f + sc[i]; Vf[3 * DM + i] = g_new[i] * s1; Vf[4 * DM + i] = b_new[i] * s1 + sh[i]; }
              else { Vf[3 * DM + i] = g_new[i]; Vf[4 * DM + i] = b_new[i]; } } }
        __syncthreads();
        const LAS f32x4* V = (const LAS f32x4*)Vf + lane;
#define SR_LOAD(rr, vv, yy, mm, rs) do { \
            const GAS v2u* yr_ = (const GAS v2u*)(F.Y + (size_t)(rr) * DM) + lane; \
            if (MODE == 0 || !ZF16) { const GAS f32x4* zr_ = (const GAS f32x4*)(MODE == 0 ? ((rr) < ML ? F.x + (size_t)(rr) * DM : F.ctx + (size_t)((rr) - ML) * DM) : F.ZF + (size_t)(rr) * DM) + lane; \
                _Pragma("unroll") for (int j = 0; j < 16; ++j) { vv[j] = zr_[64 * j]; yy[j] = yr_[64 * j]; } } \
            else { const GAS v2u* zr_ = (const GAS v2u*)((const bf16*)F.ZF + (size_t)(rr) * DM) + lane; \
                _Pragma("unroll") for (int j = 0; j < 16; ++j) { const v2u w_ = zr_[64 * j]; vv[j] = (f32x4){hlo(w_.x), hhi(w_.x), hlo(w_.y), hhi(w_.y)}; yy[j] = yr_[64 * j]; } } \
            if (MODE != 0) { mm = F.stats[2 * (rr)]; rs = F.stats[2 * (rr) + 1]; } } while (0)
#define SR_ROW(r, v, m0, r0, vn, m0n, r0n) do { \
            if ((r) >= ML && nslab > 0) { \
                _Pragma("unroll") for (int j = 0; j < 16; ++j) { f32x4 t = (f32x4){bflo(yv[j].x), bfhi(yv[j].x), bflo(yv[j].y), bfhi(yv[j].y)}; \
                    for (int p = 0; p < nslab; ++p) { const v2u w = ((const GAS v2u*)(F.YS + (size_t)p * MC * DM + (size_t)((r) - ML) * DM) + lane)[64 * j]; t = t + (f32x4){bflo(w.x), bfhi(w.x), bflo(w.y), bfhi(w.y)}; } \
                    yv[j].x = pk2(t.x, t.y); yv[j].y = pk2(t.z, t.w); } \
            } \
            float s = 0.f; \
            _Pragma("unroll") for (int j = 0; j < 16; ++j) { const f32x4 yf = (f32x4){bflo(yv[j].x), bfhi(yv[j].x), bflo(yv[j].y), bfhi(yv[j].y)}; \
                if (MODE != 0) v[j] = (v[j] - m0) * r0 * V[64 * j] + V[1024 + 64 * j] + V[2048 + 64 * j] * yf; \
                else v[j] = v[j] * ALPHA + V[2048 + 64 * j] * yf; \
                s += (v[j].x + v[j].y) + (v[j].z + v[j].w); \
                if ((j & 3) == 3) asm volatile("" ::: "memory"); } \
            SR_LOAD((r) + NWAVES < seg_end ? (r) + NWAVES : (r), vn, yv, m0n, r0n);     \
            if (MODE != 2) { if (!ZF16) { GAS f32x4* zo = (GAS f32x4*)(F.ZF + (size_t)(r) * DM) + lane; \
                _Pragma("unroll") for (int j = 0; j < 16; ++j) zo[64 * j] = v[j]; } \
              else { GAS v2u* zo = (GAS v2u*)((bf16*)F.ZF + (size_t)(r) * DM) + lane; \
                _Pragma("unroll") for (int j = 0; j < 16; ++j) { v2u w_; w_.x = pkh2(v[j].x, v[j].y); w_.y = pkh2(v[j].z, v[j].w); zo[64 * j] = w_; } } } \
            const float mean = wave_sum(s) * (1.f / DM); float s2 = 0.f; \
            _Pragma("unroll") for (int j = 0; j < 16; ++j) { v[j] = v[j] - mean; s2 += (v[j].x * v[j].x + v[j].y * v[j].y) + (v[j].z * v[j].z + v[j].w * v[j].w); } \
            const float rstd = 1.f / sqrtf(wave_sum(s2) * (1.f / DM) + LN_EPS); \
            if (MODE == 2) { GAS f32x4* ho = (GAS f32x4*)(F.out + (size_t)(r) * DM) + lane; \
                _Pragma("unroll") for (int j = 0; j < 16; ++j) { ho[64 * j] = v[j] * rstd * V[3072 + 64 * j] + V[4096 + 64 * j]; if ((j & 3) == 3) asm volatile("" ::: "memory"); } \
            } else { \
                if (lane == 0) { F.stats[2 * (r)] = mean; F.stats[2 * (r) + 1] = rstd; } \
                GAS v2u* o8 = (GAS v2u*)(F.A + (size_t)(r) * DM) + lane; \
                _Pragma("unroll") for (int j = 0; j < 16; ++j) { const f32x4 a = v[j] * rstd * V[3072 + 64 * j] + V[4096 + 64 * j]; v2u w; w.x = pk2(a.x, a.y); w.y = pk2(a.z, a.w); o8[64 * j] = w; if ((j & 3) == 3) asm volatile("" ::: "memory"); } \
            } } while (0)
        f32x4 vA[16], vB[16]; v2u yv[16]; float mA = 0.f, rA = 1.f, mB = 0.f, rB = 1.f;
        int r = ra + F.wave;
        if (r < seg_end) SR_LOAD(r, vA, yv, mA, rA);
        for (; r < seg_end; r += 2 * NWAVES) {
            SR_ROW(r, vA, mA, rA, vB, mB, rB);
            if (r + NWAVES < seg_end) SR_ROW(r + NWAVES, vB, mB, rB, vA, mA, rA);
        }
#undef SR_ROW
#undef SR_LOAD
        ra = seg_end;
    }
    __syncthreads();
}
template <int MODE>
__device__ __forceinline__ void stage_rows2(Frame& F, int nrows, const float* g_old, const float* b_old, const float* gate0, const float* g_new, const float* b_new, const float* shift0, int nslab) {
    LAS float* P = (LAS float*)(F.lds + RING_OFF);
    const int tid = tid_id(), lane = tid & 63, wv = F.wave, c0 = tid * 8;
    int par = 0;
    for (int part = 0; part < 2; ++part) {
    const int p_lo = part ? ML : 0, p_hi = part ? nrows : (nrows < ML ? nrows : ML);
    if (p_hi <= p_lo) continue;
    const int RB = (p_hi - p_lo + F.G - 1) / F.G, r_begin = p_lo + F.vcu * RB, r_end = (r_begin + RB < p_hi) ? r_begin + RB : p_hi;
    for (int ra = r_begin; ra < r_end;) {
        const int set = ra < ML ? (ra >> 12) : 4;
        int seg_end = ra < ML ? (((ra >> 12) + 1) << 12) : nrows; if (seg_end > r_end) seg_end = r_end;
        const bool slab_on = (ra >= ML) && (nslab > 0);
        float V0[8], V1[8], V2[8], V3[8], V4[8];
        { const float* gate = gate0 + (size_t)set * 6 * DM + c0; const float* sh = shift0 + (size_t)set * 6 * DM + c0; const float* sc = sh + DM;
#pragma unroll
          for (int j = 0; j < 8; ++j) {
              if (MODE != 0) { V0[j] = ALPHA * g_old[c0 + j]; V1[j] = ALPHA * b_old[c0 + j]; } else { V0[j] = 0.f; V1[j] = 0.f; }
              V2[j] = gate[j];
              if (MODE != 2) { const float s1 = 1.0f + sc[j]; V3[j] = g_new[c0 + j] * s1; V4[j] = b_new[c0 + j] * s1 + sh[j]; } else { V3[j] = g_new[c0 + j]; V4[j] = b_new[c0 + j]; } } }
        const int last = seg_end - 1;
#define R2_DECL(S) v4u zq##S = {0u, 0u, 0u, 0u}, yq##S = {0u, 0u, 0u, 0u}, s1q##S = {0u, 0u, 0u, 0u}, s2q##S = {0u, 0u, 0u, 0u}, s3q##S = {0u, 0u, 0u, 0u}; f32x4 xa##S = {0.f, 0.f, 0.f, 0.f}, xb##S = {0.f, 0.f, 0.f, 0.f}; float mq##S = 0.f, rq##S = 1.f;
#define R2_LOAD(S, rr) do { const int r_ = (rr) < last ? (rr) : last; \
            yq##S = *(const GAS v4u*)(F.Y + (size_t)r_ * DM + c0); \
            if (MODE == 0) { const float* xp_ = (r_ < ML ? F.x + (size_t)r_ * DM : F.ctx + (size_t)(r_ - ML) * DM) + c0; xa##S = *(const GAS f32x4*)xp_; xb##S = *(const GAS f32x4*)(xp_ + 4); } \
            else { zq##S = *(const GAS v4u*)((const bf16*)F.ZF + (size_t)r_ * DM + c0); mq##S = F.stats[2 * r_]; rq##S = F.stats[2 * r_ + 1]; } \
            if (slab_on) { const bf16* sp_ = F.YS + (size_t)(r_ - ML) * DM + c0; s1q##S = *(const GAS v4u*)sp_; s2q##S = *(const GAS v4u*)(sp_ + (size_t)MC * DM); s3q##S = *(const GAS v4u*)(sp_ + (size_t)2 * MC * DM); } } while (0)
#define R2_PROC(S, rr) do { if ((rr) <= last) { const int r_ = (rr); float z[8]; \
            _Pragma("unroll") for (int q = 0; q < 4; ++q) { float y0 = bflo(yq##S[q]), y1 = bfhi(yq##S[q]); \
                if (slab_on) { y0 += bflo(s1q##S[q]) + bflo(s2q##S[q]) + bflo(s3q##S[q]); y1 += bfhi(s1q##S[q]) + bfhi(s2q##S[q]) + bfhi(s3q##S[q]); } \
                if (MODE == 0) { const float x0 = q < 2 ? xa##S[2 * q] : xb##S[2 * q - 4], x1 = q < 2 ? xa##S[2 * q + 1] : xb##S[2 * q - 3]; z[2 * q] = x0 * ALPHA + V2[2 * q] * y0; z[2 * q + 1] = x1 * ALPHA + V2[2 * q + 1] * y1; } \
                else { z[2 * q] = (hlo(zq##S[q]) - mq##S) * rq##S * V0[2 * q] + V1[2 * q] + V2[2 * q] * y0; z[2 * q + 1] = (hhi(zq##S[q]) - mq##S) * rq##S * V0[2 * q + 1] + V1[2 * q + 1] + V2[2 * q + 1] * y1; } } \
            if (MODE != 2) { v4u w_; _Pragma("unroll") for (int q = 0; q < 4; ++q) w_[q] = pkh2(z[2 * q], z[2 * q + 1]); *(GAS v4u*)((bf16*)F.ZF + (size_t)r_ * DM + c0) = w_; } \
            float s_ = 0.f, q_ = 0.f; _Pragma("unroll") for (int j = 0; j < 8; ++j) { s_ += z[j]; q_ += z[j] * z[j]; } \
            s_ = wave_sum(s_); q_ = wave_sum(q_); \
            if (lane == 0) { P[(par * 8 + wv) * 2] = s_; P[(par * 8 + wv) * 2 + 1] = q_; } \
            asm volatile("s_waitcnt lgkmcnt(0)" ::: "memory"); __builtin_amdgcn_s_barrier(); asm volatile("" ::: "memory"); \
            float S_ = 0.f, Q_ = 0.f; _Pragma("unroll") for (int w = 0; w < 8; ++w) { S_ += P[(par * 8 + w) * 2]; Q_ += P[(par * 8 + w) * 2 + 1]; } \
            par ^= 1; \
            const float mean = S_ * (1.f / DM), rstd = 1.f / sqrtf(Q_ * (1.f / DM) - mean * mean + LN_EPS); \
            if (MODE == 2) { f32x4 o0, o1; _Pragma("unroll") for (int j = 0; j < 4; ++j) { o0[j] = (z[j] - mean) * rstd * V3[j] + V4[j]; o1[j] = (z[4 + j] - mean) * rstd * V3[4 + j] + V4[4 + j]; } \
                float* op_ = F.out + (size_t)r_ * DM + c0; *(GAS f32x4*)op_ = o0; *(GAS f32x4*)(op_ + 4) = o1; } \
            else { if (tid == 0) { F.stats[2 * r_] = mean; F.stats[2 * r_ + 1] = rstd; } \
                v4u w_; _Pragma("unroll") for (int q = 0; q < 4; ++q) w_[q] = pk2((z[2 * q] - mean) * rstd * V3[2 * q] + V4[2 * q], (z[2 * q + 1] - mean) * rstd * V3[2 * q + 1] + V4[2 * q + 1]); \
                *(GAS v4u*)(F.A + (size_t)r_ * DM + c0) = w_; } } } while (0)
        R2_DECL(0) R2_DECL(1) R2_DECL(2) R2_DECL(3)
        R2_LOAD(0, ra); R2_LOAD(1, ra + 1); R2_LOAD(2, ra + 2);
        for (int r = ra; r < seg_end; r += 4) {
            R2_LOAD(3, r + 3); R2_PROC(0, r);
            R2_LOAD(0, r + 4); R2_PROC(1, r + 1);
            R2_LOAD(1, r + 5); R2_PROC(2, r + 2);
            R2_LOAD(2, r + 6); R2_PROC(3, r + 3);
        }
#undef R2_DECL
#undef R2_LOAD
#undef R2_PROC
        ra = seg_end;
    }
    }
    __syncthreads();
}
__device__ __forceinline__ void p3_conv(Frame& F) {
    const int gw = F.vcu * NWAVES + F.wave, NGW = F.G * NWAVES;
    for (int it = gw; it < (MT / 16) * 8; it += NGW) {
        const int rb = it >> 3, cc = it & 7, r0 = rb * 16, col = cc * 512 + lane_id() * 8;
        const int t0 = r0 < ML ? (r0 & (SEQ - 1)) : ((r0 - ML) & (CTXL - 1)), slen = r0 < ML ? SEQ : CTXL;
        float w0[8], w1[8], w2[8], cb[8];
#pragma unroll
        for (int j = 0; j < 8; ++j) { w0[j] = F.conv_w[col + j]; w1[j] = F.conv_w[DM + col + j]; w2[j] = F.conv_w[2 * DM + col + j]; cb[j] = F.conv_b[col + j]; }
        const GAS v4u* up = (const GAS v4u*)(F.U + (size_t)r0 * DM + col); const GAS v4u* gp = (const GAS v4u*)(F.GB + (size_t)r0 * DM + col); GAS v4u* zp = (GAS v4u*)(F.Z + (size_t)r0 * DM + col);
        const v4u zero = (v4u){0u, 0u, 0u, 0u};
        v4u prev = t0 > 0 ? up[-(DM / 8)] : zero, cur = up[0];
#pragma unroll 4
        for (int i = 0; i < 16; ++i) {
            const v4u nxt = (i < 15 || t0 + 16 < slen) ? up[(size_t)(i + 1) * (DM / 8)] : zero;
            const v4u gb = gp[(size_t)i * (DM / 8)];
            v4u o;
#pragma unroll
            for (int q = 0; q < 4; ++q) {
                const float c0 = bflo(prev[q]) * w0[2 * q] + bflo(cur[q]) * w1[2 * q] + bflo(nxt[q]) * w2[2 * q] + cb[2 * q];
                const float c1 = bfhi(prev[q]) * w0[2 * q + 1] + bfhi(cur[q]) * w1[2 * q + 1] + bfhi(nxt[q]) * w2[2 * q + 1] + cb[2 * q + 1];
                o[q] = pk2(bflo(gb[q]) * c0, bfhi(gb[q]) * c1); }
            zp[(size_t)i * (DM / 8)] = o; prev = cur; cur = nxt;
        }
    }
}
__device__ __forceinline__ void rms_rope8f(float (&x)[8], const float* gain8, const float* cs, bool rope, int lane) {
    float ss = 0.f;
#pragma unroll
    for (int j = 0; j < 8; ++j) ss += x[j] * x[j];
    ss += __shfl_xor(ss, 1); ss += __shfl_xor(ss, 2); ss += __shfl_xor(ss, 4); ss += __shfl_xor(ss, 8);
    const float rs = 1.f / sqrtf(ss * (1.f / HD) + RMS_EPS);
#pragma unroll
    for (int j = 0; j < 8; ++j) x[j] = x[j] * rs * gain8[j];
    if (rope) {
        const bool hi = (lane >> 2) & 1;
#pragma unroll
        for (int j = 0; j < 8; ++j) { const float p = __shfl_xor(x[j], 4); x[j] = x[j] * cs[2 * j] + (hi ? p : -p) * cs[2 * j + 1]; }
    }
}
__device__ __forceinline__ void rms_rope8(v4u& w, const float* gain8, const float* cs, bool rope, int lane) {
    float x[8];
#pragma unroll
    for (int q = 0; q < 4; ++q) { x[2 * q] = bflo(w[q]); x[2 * q + 1] = bfhi(w[q]); }
    rms_rope8f(x, gain8, cs, rope, lane);
#pragma unroll
    for (int q = 0; q < 4; ++q) w[q] = pk2(x[2 * q], x[2 * q + 1]);
}
__device__ __forceinline__ void p10_qknorm(Frame& F) {
    const int gw = F.vcu * NWAVES + F.wave, NGW = F.G * NWAVES;
    const int l16 = lane_id() & 15, axis = l16 >> 3, f0 = (l16 & 3) * 8;
    float qg[8], kg[8];
#pragma unroll
    for (int j = 0; j < 8; ++j) { qg[j] = F.q_gain[l16 * 8 + j]; kg[j] = F.k_gain[l16 * 8 + j]; }
    for (int r = ML + gw; r < ML + NB * SKV; r += NGW) {
        if (r < ML) {
            const int t = r & (SEQ - 1), pos = axis ? (t & 63) : (t >> 6);
            float cs[16];
#pragma unroll
            for (int j = 0; j < 4; ++j) { const f32x4 c4 = *(const GAS f32x4*)(F.rope + (size_t)(pos * 32 + f0) * 2 + 4 * j); cs[4 * j] = c4.x; cs[4 * j + 1] = c4.y; cs[4 * j + 2] = c4.z; cs[4 * j + 3] = c4.w; }
            GAS v4u* qp = (GAS v4u*)(F.Q + (size_t)r * DM) + lane_id();
#pragma unroll
            for (int j = 0; j < 8; ++j) { v4u w = qp[64 * j]; rms_rope8(w, qg, cs, true, lane_id()); qp[64 * j] = w; }
        } else {
            const int kr = r - ML, bb = kr / SKV, tk = kr - bb * SKV;
            GAS v4u* kp = (GAS v4u*)(F.K + (size_t)kr * KVD) + lane_id();
            if (tk >= CTXL) {
                const int t = tk - CTXL, pos = axis ? (t & 63) : (t >> 6);
                float cs[16];
#pragma unroll
                for (int j = 0; j < 4; ++j) { const f32x4 c4 = *(const GAS f32x4*)(F.rope + (size_t)(pos * 32 + f0) * 2 + 4 * j); cs[4 * j] = c4.x; cs[4 * j + 1] = c4.y; cs[4 * j + 2] = c4.z; cs[4 * j + 3] = c4.w; }
#pragma unroll
                for (int j = 0; j < 2; ++j) { v4u w = kp[64 * j]; rms_rope8(w, kg, cs, true, lane_id()); kp[64 * j] = w; }
            } else {
                const float* sp = F.slab + (size_t)(bb * CTXL + tk) * 2048 + lane_id() * 8;
                GAS v4u* vp = (GAS v4u*)(F.V + (size_t)kr * KVD) + lane_id();
#pragma unroll
                for (int j = 0; j < 4; ++j) {
                    f32x4 a = (f32x4){0.f, 0.f, 0.f, 0.f}, c = a;
#pragma unroll
                    for (int p = 0; p < 8; ++p) { a = a + *(const GAS f32x4*)(sp + (size_t)p * 1024 * 2048 + 512 * j); c = c + *(const GAS f32x4*)(sp + (size_t)p * 1024 * 2048 + 512 * j + 4); }
                    float x[8] = {a.x, a.y, a.z, a.w, c.x, c.y, c.z, c.w};
                    if (j < 2) rms_rope8f(x, kg, x, false, lane_id());
                    v4u w;
#pragma unroll
                    for (int q = 0; q < 4; ++q) w[q] = pk2(x[2 * q], x[2 * q + 1]);
                    if (j < 2) kp[64 * j] = w; else vp[64 * (j - 2)] = w;
                }
            }
        }
    }
}

#ifndef MK_SPLIT
#define MK_SPLIT 0
#endif
#ifndef REPMASK
#define REPMASK 0
#endif
#define REP(k, ...) do { { __VA_ARGS__ } if constexpr (((REPMASK >> (k)) & 1) != 0) { GRID_BAR(); { __VA_ARGS__ } } } while (0)
constexpr int N_PHASES = 17;
struct Args { const float* in[18]; float* out; unsigned char* ws; int ph_lo, ph_hi; };
__global__ void __launch_bounds__(NWAVES * 64, 2) dit_fwd(Args args) {
    extern __shared__ __attribute__((aligned(16))) unsigned char lds[];
    Frame F0;
    F0.lds = (LAS unsigned char*)lds;
    F0.MISC = (volatile LAS unsigned*)(F0.lds + MISC_OFF);
    F0.tid = threadIdx.x; F0.wave = __builtin_amdgcn_readfirstlane(F0.tid >> 6);
    F0.G = gridDim.x; { const int bx = blockIdx.x; F0.vcu = (F0.G % 8 == 0) ? (bx % 8) * (F0.G / 8) + bx / 8 : bx; }
    F0.x = F0.c = F0.ctx = F0.cctx = F0.ada_w = F0.ada_b = F0.ln_g = F0.ln_b = F0.mlp_w1 = F0.mlp_w2 = F0.conv_in_w = F0.conv_w = F0.conv_b = F0.conv_out_w = F0.qkv_w = F0.q_gain = F0.k_gain = F0.out_w = nullptr; F0.out = nullptr;
    F0.mod = F0.rope = F0.ZF = F0.slab = F0.stats = nullptr; F0.Wci = F0.Wco = F0.W1a = F0.W2a = F0.Wqkv = F0.Wo = F0.W1b = F0.W2b = F0.A = F0.BIG = F0.GB = F0.U = F0.Z = F0.Q = F0.K = F0.V = F0.O = F0.Y = F0.YS = nullptr;
    gu32* const ctl = (gu32*)(args.ws + WS_CTL);
    for (int u = F0.tid; u < (LDS_BYTES - LDSCTL_OFF) / 4; u += NWAVES * 64) ((LAS unsigned*)(F0.lds + LDSCTL_OFF))[u] = 0u;
    __syncthreads();
    XcdBarrier bar; bar.bar = (unsigned*)(ctl + CW_BAR); bar.x = 0; bar.st = nullptr;
    if (!MK_SPLIT) bar = xcd_barrier_post((unsigned*)(ctl + CW_BAR), F0.MISC + 8);
#ifndef BARREP
#define BARREP 1
#endif
#define GRID_BAR() do { if (!MK_SPLIT) { for (int b_ = 0; b_ < BARREP; ++b_) xcd_barrier(bar); } } while (0)
    const int lo = args.ph_lo, hi = args.ph_hi;
#define IN(k) (lo <= (k) && (k) < hi)
#define BOTH(k) (IN(k) && IN((k) + 1))
#define mod0 (F.mod)
#define mod1 (F.mod + (size_t)5 * NMOD * DM)

    if (IN(0)) { REP(0, PH_BEGIN  p0_adaln(F); __syncthreads(); p0_weights(F); __syncthreads(); ); if (BOTH(0)) GRID_BAR(); }
    if (IN(1)) { REP(1, PH_BEGIN  p1_modulate(F); ); if (BOTH(1)) GRID_BAR(); }
    if (IN(2)) { REP(2, PH_BEGIN  pg8::Gemm g{F.A, F.Wci, MT, 3 * DM, DM}; pg8::StaticOrder S; S.init(MT, 3 * DM, DM, F.G, F.vcu); pg8::EpiConvIn E{F.GB, F.U};
        pg8::gemm_phase<pg8::EpiConvIn, pg8::StaticOrder, true, true>(F.lds + RING_OFF, g, S, E); ); if (BOTH(2)) GRID_BAR(); }
    if (IN(3)) { REP(3, PH_BEGIN  p3_conv(F); ); if (BOTH(3)) GRID_BAR(); }
    if (IN(4)) { REP(4, PH_BEGIN  pg8::Gemm g{F.Z, F.Wco, MT, DM, DM}; pg8::SplitOrder S; S.init(DM, DM, 4, F.G, F.vcu); pg8::EpiY E{F.Y, F.YS};
        pg8::gemm_phase<pg8::EpiY, pg8::SplitOrder, true, true>(F.lds + RING_OFF, g, S, E); ); if (BOTH(4)) GRID_BAR(); }
    if (IN(5)) { REP(5, PH_BEGIN  stage_rows2<0>(F, MT, nullptr, nullptr, mod0 + 2 * DM, F.ln_g, F.ln_b, mod0 + 3 * DM, 3); ); if (BOTH(5)) GRID_BAR(); }
    if (IN(6)) { REP(6, PH_BEGIN  pg8::Gemm g{F.A, F.W1a, MT, FF, DM}; pg8::StaticOrder S; S.init(MT, FF, DM, F.G, F.vcu); pg8::EpiSqRelu E{F.BIG, FF};
        pg8::gemm_phase<pg8::EpiSqRelu, pg8::StaticOrder, true, true>(F.lds + RING_OFF, g, S, E); ); if (BOTH(6)) GRID_BAR(); }
    if (IN(7)) { REP(7, PH_BEGIN  pg8::Gemm g{F.BIG, F.W2a, MT, DM, FF}; pg8::SplitOrder S; S.init(DM, FF, 4, F.G, F.vcu); pg8::EpiY E{F.Y, F.YS};
        pg8::gemm_phase<pg8::EpiY, pg8::SplitOrder, true, true>(F.lds + RING_OFF, g, S, E); ); if (BOTH(7)) GRID_BAR(); }
    if (IN(8)) { REP(8, PH_BEGIN  stage_rows2<1>(F, MT, F.ln_g, F.ln_b, mod0 + 5 * DM, F.ln_g + DM, F.ln_b + DM, mod1 + 0 * DM, 3); ); if (BOTH(8)) GRID_BAR(); }
    if (IN(9)) { REP(9, PH_BEGIN  pg8::Gemm g{F.A, F.Wqkv, MT, NQKV, DM}; pg8::SplitOrder S; S.init(NQKV, DM, 8, F.G, F.vcu, 16, 8); pg8::EpiQKV E{F.Q, F.K, F.V, F.slab};
        pg8::gemm_phase<pg8::EpiQKV, pg8::SplitOrder, true, true>(F.lds + RING_OFF, g, S, E); ); if (BOTH(9)) GRID_BAR(); }
    if (IN(10)) { REP(10, PH_BEGIN  p10_qknorm(F); ); if (BOTH(10)) GRID_BAR(); }
    if (IN(11)) { REP(11, PH_BEGIN
        bool bound_ok; { const int l_ = lane_id(); float gq = fmaxf(fabsf(F.q_gain[l_]), fabsf(F.q_gain[64 + l_])), gk = fmaxf(fabsf(F.k_gain[l_]), fabsf(F.k_gain[64 + l_]));
            _Pragma("unroll") for (int o_ = 1; o_ < 64; o_ <<= 1) { gq = fmaxf(gq, __shfl_xor(gq, o_)); gk = fmaxf(gk, __shfl_xor(gk, o_)); }
            const float b2 = 11.313708499f * 1.4426950408889634f * gq * gk; bound_ok = __builtin_amdgcn_readfirstlane((b2 < 100.f) ? 1 : 0) != 0; }
        if (bound_ok) {
        for (int i = 0;; ++i) {
            int pair, idx;
            if (F.G == 256) { if (i >= 8) break; pair = (blockIdx.x & 7) * 4 + (i >> 1); idx = (i & 1) * 32 + (blockIdx.x >> 3); }
            else { const int uu = i * F.G + blockIdx.x; if (uu >= NB * HKV * 64) break; pair = uu >> 6; idx = uu & 63; }
            const int b = pair >> 3, kvh = pair & 7, h = kvh * 4 + (idx >> 4), qb = idx & 15;
            const size_t q0 = ((size_t)(b * SEQ + qb * 256) * HQ + h) * HD, k0 = ((size_t)b * SKV * HKV + kvh) * HD;
            attn::attn_body_c16((const attn::bf16*)F.Q + q0, (const attn::bf16*)F.K + k0, (const attn::bf16*)F.V + k0, (attn::bf16*)F.O + q0, (char*)lds + RING_OFF, F.lds + RING_OFF, F.q_gain, F.rope, qb * 256);
            __syncthreads();
        }
        } else {
        for (int i = 0;; ++i) {
            int pair, idx;
            if (F.G == 256) { if (i >= 8) break; pair = (blockIdx.x & 7) * 4 + (i >> 1); idx = (i & 1) * 32 + (blockIdx.x >> 3); }
            else { const int uu = i * F.G + blockIdx.x; if (uu >= NB * HKV * 64) break; pair = uu >> 6; idx = uu & 63; }
            const int b = pair >> 3, kvh = pair & 7, h = kvh * 4 + (idx >> 4), qb = idx & 15;
            const size_t q0 = ((size_t)(b * SEQ + qb * 256) * HQ + h) * HD, k0 = ((size_t)b * SKV * HKV + kvh) * HD;
            attn::attn_dense_body<attn::bf16, false>((const attn::bf16*)F.Q + q0, (const attn::bf16*)F.K + k0, (const attn::bf16*)F.V + k0, (attn::bf16*)F.O + q0, SKV, (char*)lds + RING_OFF, F.q_gain, F.rope, qb * 256);
            __syncthreads();
        }
        }
        ); if (BOTH(11)) GRID_BAR();
    }
    if (IN(12)) { REP(12, PH_BEGIN  pg8::Gemm g{F.O, F.Wo, ML, DM, DM}; pg8::StaticOrder S; S.init(ML, DM, DM, F.G, F.vcu); pg8::EpiY E{F.Y, F.YS};
        pg8::gemm_phase<pg8::EpiY, pg8::StaticOrder, true, true>(F.lds + RING_OFF, g, S, E); ); if (BOTH(12)) GRID_BAR(); }
    if (IN(13)) { REP(13, PH_BEGIN  stage_rows2<1>(F, ML, F.ln_g + DM, F.ln_b + DM, mod1 + 2 * DM, F.ln_g + 2 * DM, F.ln_b + 2 * DM, mod1 + 3 * DM, 0); ); if (BOTH(13)) GRID_BAR(); }
    if (IN(14)) { REP(14, PH_BEGIN  pg8::Gemm g{F.A, F.W1b, ML, FF, DM}; pg8::StaticOrder S; S.init(ML, FF, DM, F.G, F.vcu); pg8::EpiSqRelu E{F.BIG, FF};
        pg8::gemm_phase<pg8::EpiSqRelu, pg8::StaticOrder, true, true>(F.lds + RING_OFF, g, S, E); ); if (BOTH(14)) GRID_BAR(); }
    if (IN(15)) { REP(15, PH_BEGIN  pg8::Gemm g{F.BIG, F.W2b, ML, DM, FF}; pg8::StaticOrder S; S.init(ML, DM, FF, F.G, F.vcu); pg8::EpiY E{F.Y, F.YS};
        pg8::gemm_phase<pg8::EpiY, pg8::StaticOrder, true, true>(F.lds + RING_OFF, g, S, E); ); if (BOTH(15)) GRID_BAR(); }
    if (IN(16)) { REP(16, PH_BEGIN  stage_rows2<2>(F, ML, F.ln_g + 2 * DM, F.ln_b + 2 * DM, mod1 + 5 * DM, F.ln_g + 3 * DM, F.ln_b + 3 * DM, mod1, 0); ); }
#undef IN
#undef BOTH
}

extern "C" void kernel_launch(void* const* d_in, const int* in_sizes, int n_in, void* d_out, int out_size, void* d_ws, size_t ws_size, hipStream_t stream) {
    static int grid = 0;
    if (grid == 0) {
        if (n_in != 18 || in_sizes[0] != ML * DM || out_size != ML * DM || ws_size < WS_END) { fprintf(stderr, "kernel_launch: built for 18 inputs, x/out of %d floats, >= %zu bytes of workspace; got n_in %d, in0 %d, out %d, ws %zu; nothing launched\n", ML * DM, (size_t)WS_END, n_in, n_in > 0 ? in_sizes[0] : -1, out_size, ws_size); grid = -1; return; }
        int dev = 0, cus = 0, per_cu = 0;
        if (hipGetDevice(&dev) != hipSuccess || hipDeviceGetAttribute(&cus, hipDeviceAttributeMultiprocessorCount, dev) != hipSuccess) { fprintf(stderr, "kernel_launch: hipGetDevice / hipDeviceGetAttribute failed\n"); grid = -1; return; }
        if (hipFuncSetAttribute((const void*)dit_fwd, hipFuncAttributeMaxDynamicSharedMemorySize, LDS_BYTES) != hipSuccess) { fprintf(stderr, "kernel_launch: hipFuncSetAttribute failed\n"); grid = -1; return; }
        if (hipOccupancyMaxActiveBlocksPerMultiprocessor(&per_cu, (const void*)dit_fwd, NWAVES * 64, LDS_BYTES) != hipSuccess || per_cu < 1) { fprintf(stderr, "kernel_launch: occupancy query reports %d workgroups per CU; nothing launched\n", per_cu); (void)hipGetLastError(); grid = -1; return; }
        grid = cus;
    }
    if (grid < 0) return;
    if (hipMemsetAsync((char*)d_ws + WS_CTL, 0, CTL_ZERO_BYTES, stream) != hipSuccess) { fprintf(stderr, "kernel_launch: hipMemsetAsync failed\n"); return; }
    Args a{};
    for (int i = 0; i < 18; ++i) a.in[i] = (const float*)d_in[i];
    a.out = (float*)d_out; a.ws = (unsigned char*)d_ws;
#if MK_SPLIT
    for (int p = 0; p < N_PHASES; ++p) { a.ph_lo = p; a.ph_hi = p + 1; hipLaunchKernelGGL(dit_fwd, dim3(grid), dim3(NWAVES * 64), LDS_BYTES, stream, a); }
#else
    a.ph_lo = 0; a.ph_hi = N_PHASES;
    hipLaunchKernelGGL(dit_fwd, dim3(grid), dim3(NWAVES * 64), LDS_BYTES, stream, a);
#endif
    const hipError_t le = hipPeekAtLastError();
    if (le != hipSuccess) fprintf(stderr, "kernel_launch: launch failed: %s (grid %d x %d threads, %d B LDS)\n", hipGetErrorName(le), grid, NWAVES * 64, LDS_BYTES);
}
```
